# Optimizing an MI355X kernel written in HIP

```python
import math
import jax, jax.numpy as jnp
from jax import lax
import numpy as np

D_MODEL = 1024
BATCH = 2
SEQ = 8192
DEPTH = 1
DEC_BATCH = 4
DEC_SEQ = 4096
PAST_LEN = 128

MIX_WIDTH = D_MODEL
MLA_HEADS = 8
QK_NOPE = 64
QK_ROPE = 32
V_HEAD = 64
MLA_WIDTH = MLA_HEADS * V_HEAD
Q_LORA = 256
KV_LORA = 256
FNET_GROUPS = 4
FNET_WIDTH = MIX_WIDTH - MLA_WIDTH
FNET_GROUP_DIM = FNET_WIDTH // FNET_GROUPS
IN_COLS = Q_LORA + KV_LORA + QK_ROPE + FNET_WIDTH
D_FF = 2816
CONV_W = 3
ROPE_THETA = 10000.0
RMS_EPS = 1e-6
Q_BLOCK = 128
ATTN_SCALE = 1.0 / math.sqrt(QK_NOPE + QK_ROPE)

kernel_name = "hybrid_mla_fnet_convffn_encoder"


def rmsnorm(x, g):
    xf = x.astype(jnp.float32)
    out = xf * lax.rsqrt(jnp.mean(xf * xf, axis=-1, keepdims=True) + RMS_EPS)
    return (out * g.astype(jnp.float32)).astype(x.dtype)


def rope_tables(seq_len):
    pos = jnp.arange(seq_len, dtype=jnp.float32)
    inv_freq = ROPE_THETA ** (-jnp.arange(0, QK_ROPE, 2, dtype=jnp.float32) / QK_ROPE)
    ang = pos[:, None] * inv_freq[None, :]
    return jnp.cos(ang), jnp.sin(ang)


def apply_rope(x, cos, sin):
    xf = x.astype(jnp.float32)
    x1, x2 = jnp.split(xf, 2, axis=-1)
    out = jnp.concatenate([x1 * cos - x2 * sin, x2 * cos + x1 * sin], axis=-1)
    return out.astype(x.dtype)


def mla(c_q, c_kv, k_rope_raw, g_q, w_uq, g_kv, w_ukv):
    b, s, _ = c_q.shape
    cos, sin = rope_tables(s)
    q = (rmsnorm(c_q, g_q) @ w_uq).reshape(b, s, MLA_HEADS, QK_NOPE + QK_ROPE)
    q_nope = q[..., :QK_NOPE]
    q_rope = apply_rope(q[..., QK_NOPE:], cos[None, :, None, :], sin[None, :, None, :])
    kv = (rmsnorm(c_kv, g_kv) @ w_ukv).reshape(b, s, MLA_HEADS, QK_NOPE + V_HEAD)
    k_nope = kv[..., :QK_NOPE]
    v = kv[..., QK_NOPE:]
    k_rope = apply_rope(k_rope_raw, cos[None], sin[None])

    nb = s // Q_BLOCK
    qn_blk = q_nope.reshape(b, nb, Q_BLOCK, MLA_HEADS, QK_NOPE).transpose(1, 0, 2, 3, 4)
    qr_blk = q_rope.reshape(b, nb, Q_BLOCK, MLA_HEADS, QK_ROPE).transpose(1, 0, 2, 3, 4)

    def block(args):
        qn, qr = args
        scores = (jnp.einsum('bqhd,bkhd->bhqk', qn, k_nope, preferred_element_type=jnp.float32)
                  + jnp.einsum('bqhr,bkr->bhqk', qr, k_rope, preferred_element_type=jnp.float32)) * ATTN_SCALE
        probs = jax.nn.softmax(scores, axis=-1).astype(v.dtype)
        return jnp.einsum('bhqk,bkhd->bqhd', probs, v)

    out = lax.map(block, (qn_blk, qr_blk))
    return out.transpose(1, 0, 2, 3, 4).reshape(b, s, MLA_WIDTH)


def fourier_mix(u, w_fnet):
    b, s, _ = u.shape
    ug = u.reshape(b, s, FNET_GROUPS, FNET_GROUP_DIM).astype(jnp.float32)
    fr = jnp.fft.fftn(ug, axes=(1, 3), norm="ortho").real.astype(u.dtype)
    out = jnp.einsum('bsgc,gcd->bsgd', fr, w_fnet)
    return out.reshape(b, s, FNET_WIDTH)


def dwconv_centred(h, w, bias):
    s = h.shape[1]
    half = CONV_W // 2
    hp = jnp.pad(h, ((0, 0), (half, half), (0, 0)))
    out = bias
    for j in range(CONV_W):
        out = out + hp[:, j:j + s, :] * w[j]
    return out


def conv_ffn(h, w_gate, w_up, conv_w, conv_b, w_down):
    gate = dwconv_centred(h @ w_gate, conv_w, conv_b)
    act = jax.nn.gelu(gate, approximate=True) * (h @ w_up)
    return act @ w_down


def trunk(x, g_pre_mix, w_in, g_q, w_uq, g_kv, w_ukv, w_fnet, w_out, g_post_mix,
          g_pre_ffn, w_gate, w_up, conv_w, conv_b, w_down, g_post_ffn):
    for l in range(DEPTH):
        h = rmsnorm(x, g_pre_mix[l])
        p = h @ w_in[l]
        c_q = p[..., :Q_LORA]
        c_kv = p[..., Q_LORA:Q_LORA + KV_LORA]
        k_rope = p[..., Q_LORA + KV_LORA:Q_LORA + KV_LORA + QK_ROPE]
        f_in = p[..., Q_LORA + KV_LORA + QK_ROPE:]
        a = mla(c_q, c_kv, k_rope, g_q[l], w_uq[l], g_kv[l], w_ukv[l])
        f = fourier_mix(f_in, w_fnet[l])
        mix = jnp.concatenate([a, f], axis=-1) @ w_out[l]
        x = x + rmsnorm(mix, g_post_mix[l])
        h = rmsnorm(x, g_pre_ffn[l])
        x = x + rmsnorm(conv_ffn(h, w_gate[l], w_up[l], conv_w[l], conv_b[l], w_down[l]), g_post_ffn[l])
    return x


def setup_inputs(seed: int = 0) -> dict:
    key = jax.random.key(seed)
    ks = jax.random.split(key, 20)
    f32 = jnp.float32

    def nrm(k, shape, fan_in):
        return jax.random.normal(k, shape, f32) * (fan_in ** -0.5)

    def gain(k, dim):
        return 1.0 + 0.02 * jax.random.normal(k, (DEPTH, dim), f32)

    return {
        "x_prompt": jax.random.normal(ks[0], (BATCH, SEQ, D_MODEL), f32),
        "x_sample": jax.random.normal(ks[1], (DEC_BATCH, DEC_SEQ, D_MODEL), f32),
        "g_pre_mix": gain(ks[2], D_MODEL),
        "w_in": nrm(ks[3], (DEPTH, D_MODEL, IN_COLS), D_MODEL),
        "g_q": gain(ks[4], Q_LORA),
        "w_uq": nrm(ks[5], (DEPTH, Q_LORA, MLA_HEADS * (QK_NOPE + QK_ROPE)), Q_LORA),
        "g_kv": gain(ks[6], KV_LORA),
        "w_ukv": nrm(ks[7], (DEPTH, KV_LORA, MLA_HEADS * (QK_NOPE + V_HEAD)), KV_LORA),
        "w_fnet": nrm(ks[8], (DEPTH, FNET_GROUPS, FNET_GROUP_DIM, FNET_GROUP_DIM), FNET_GROUP_DIM),
        "w_out": nrm(ks[9], (DEPTH, MIX_WIDTH, D_MODEL), MIX_WIDTH),
        "g_post_mix": gain(ks[10], D_MODEL),
        "g_pre_ffn": gain(ks[11], D_MODEL),
        "w_gate": nrm(ks[12], (DEPTH, D_MODEL, D_FF), D_MODEL),
        "w_up": nrm(ks[13], (DEPTH, D_MODEL, D_FF), D_MODEL),
        "conv_w": nrm(ks[14], (DEPTH, CONV_W, D_FF), CONV_W),
        "conv_b": 0.01 * jax.random.normal(ks[15], (DEPTH, D_FF), f32),
        "w_down": nrm(ks[16], (DEPTH, D_FF, D_MODEL), D_FF),
        "g_post_ffn": gain(ks[17], D_MODEL),
    }


def reference(x_prompt, x_sample, g_pre_mix, w_in, g_q, w_uq, g_kv, w_ukv, w_fnet, w_out,
              g_post_mix, g_pre_ffn, w_gate, w_up, conv_w, conv_b, w_down, g_post_ffn):
    y_prompt = trunk(x_prompt, g_pre_mix, w_in, g_q, w_uq, g_kv, w_ukv, w_fnet, w_out, g_post_mix,
                     g_pre_ffn, w_gate, w_up, conv_w, conv_b, w_down, g_post_ffn)
    y_sample = trunk(x_sample, g_pre_mix, w_in, g_q, w_uq, g_kv, w_ukv, w_fnet, w_out, g_post_mix,
                     g_pre_ffn, w_gate, w_up, conv_w, conv_b, w_down, g_post_ffn)
    return (y_prompt, y_sample)
```

```cpp
#include <hip/hip_runtime.h>
#include <hip/hip_cooperative_groups.h>
#include <cstdio>
namespace cg = cooperative_groups;

namespace pg8 {
#define PG8_LAS __attribute__((address_space(3)))
typedef unsigned short bf16_t;
typedef short bf16x8 __attribute__((ext_vector_type(8)));
typedef float f32x4 __attribute__((ext_vector_type(4)));
typedef unsigned u32x4 __attribute__((ext_vector_type(4)));
constexpr int BM = 256, BK = 64, HALF = 128, HTB = HALF * BK * 2  , STAGE_BYTES = 8 * HTB, NXCD = 8, WGM = 8;

__host__ __device__ __forceinline__ int lds_byte(int r, int c) { const int st = (r >> 4) * 2 + (c >> 5), rr = r & 15, cc = c & 31, ob = rr * 64 + cc * 2; return st * 1024 + (ob ^ (((ob >> 9) & 1) << 5)); }
__host__ __device__ __forceinline__ void stage_rc(int b, int& R, int& C) { const int st = b / 1024, sb = b % 1024, swz = sb ^ (((sb >> 9) & 1) << 5); R = (st >> 1) * 16 + swz / 64; C = (st & 1) * 32 + (swz % 64) / 2; }
__host__ __device__ __forceinline__ int perm32(int rho) { const int n = rho >> 4, i = rho & 15; return 8 * (i >> 2) + 4 * n + (i & 3); }

struct Unit { int pm, pn; };
struct Gemm { const bf16_t* A; const bf16_t* Bt; int M, N, K; };

struct StaticOrder {
    int nM, nN, nwg, G, c;
    __host__ __device__ void init(int M, int N, int G_, int c_) { nM = M / BM; nN = N / BM; nwg = nM * nN; G = G_; c = c_; }
    __host__ __device__ bool next(int i, Unit& u) const {
        const long L = (long)i * G + c; if (L >= nwg) return false;
        int wgid = (int)L; { const int q = nwg / NXCD, r = nwg % NXCD, xcd = wgid % NXCD, off = wgid / NXCD; wgid = (xcd < r ? xcd * (q + 1) : r * (q + 1) + (xcd - r) * q) + off; }
        const int nig = WGM * nN, gid = wgid / nig, fm = gid * WGM, gsz = (nM - fm) < WGM ? (nM - fm) : WGM;
        u.pm = fm + ((wgid % nig) % gsz); u.pn = (wgid % nig) / gsz; return true;
    }
    __device__ __forceinline__ void a_ready(const Unit&) const {}
    __device__ __forceinline__ void done(const Unit&) const {}
};

template <class Epi, class Sched>
__device__ __forceinline__ void gemm_phase(PG8_LAS unsigned char* lds, const Gemm g, const Sched& S, const Epi& E) {
    int tid_ = threadIdx.x; asm volatile("" : "+v"(tid_));
    const int tid = tid_, wid = __builtin_amdgcn_readfirstlane(tid >> 6), lane = tid & 63, wr = wid >> 2, wc = wid & 3, fr = lane & 15, fq = lane >> 4;
    const int K = g.K, nt = K / BK;
#define PG8_STAMP() do {} while (0)
    PG8_STAMP();
    unsigned voffA[2], voffB[2];
#pragma unroll
    for (int i = 0; i < 2; ++i) { int R, C; stage_rc(tid * 16 + i * 8192, R, C); const int Rb = Epi::PERM ? ((R & ~31) + perm32(R & 31)) : R;
        voffA[i] = (unsigned)(R * K + C) * 2u; voffB[i] = (unsigned)(Rb * K + C) * 2u; }
    const size_t kstep = (size_t)(BK * 2);
    const size_t hstep = (size_t)HALF * K * 2;
    const size_t tstep = 2 * hstep;
    const unsigned ldsw = (unsigned)wid * 1024u;
    const int aoff = lds_byte(wr * 64 + fr, fq * 8), boff = lds_byte(wc * 32 + fr, fq * 8);
#define PG8_SA(b, h) (((b) * 2 + (h)) * HTB)
#define PG8_SB(b, h) ((4 + (b) * 2 + (h)) * HTB)
#define PG8_STAGE(bufoff, gbase, voff) do { _Pragma("unroll") for (int _i = 0; _i < 2; ++_i) \
        __builtin_amdgcn_global_load_lds((const unsigned*)((const char*)(gbase) + (voff)[_i]), (PG8_LAS unsigned*)(lds + (bufoff) + ldsw + _i * 8192), 16, 0, 0); } while (0)
#define PG8_LDA(dst, b, h) do { _Pragma("unroll") for (int m = 0; m < 4; ++m) _Pragma("unroll") for (int k = 0; k < 2; ++k) dst[m][k] = *(const PG8_LAS bf16x8*)(lds + PG8_SA(b, h) + aoff + m * 2048 + k * 1024); } while (0)
#define PG8_LDB(dst, b, h) do { _Pragma("unroll") for (int n = 0; n < 2; ++n) _Pragma("unroll") for (int k = 0; k < 2; ++k) dst[n][k] = *(const PG8_LAS bf16x8*)(lds + PG8_SB(b, h) + boff + n * 2048 + k * 1024); } while (0)
#define PG8_MMA(ai, bj, At, Bt) do { __builtin_amdgcn_s_setprio(1); _Pragma("unroll") for (int m = 0; m < 4; ++m) _Pragma("unroll") for (int n = 0; n < 2; ++n) _Pragma("unroll") for (int k = 0; k < 2; ++k) \
        acc[ai][bj][m][n] = __builtin_amdgcn_mfma_f32_16x16x32_bf16(Bt[n][k], At[m][k], acc[ai][bj][m][n], 0, 0, 0); __builtin_amdgcn_s_setprio(0); } while (0)
#define PG8_WAIT_V(n) asm volatile("s_waitcnt vmcnt(" #n ")" ::: "memory")
#define PG8_WAIT_L(n) asm volatile("s_waitcnt lgkmcnt(" #n ")" ::: "memory")
#define PG8_BAR __builtin_amdgcn_s_barrier()
#define PG8_SCHED __builtin_amdgcn_sched_barrier(0)
    Unit cur, nxt; int ui = 0;
    if (!S.next(0, cur)) return;
    f32x4 acc[2][2][4][2];
#pragma unroll
    for (int a = 0; a < 2; ++a)
#pragma unroll
        for (int b = 0; b < 2; ++b)
#pragma unroll
            for (int m = 0; m < 4; ++m)
#pragma unroll
                for (int n = 0; n < 2; ++n) acc[a][b][m][n] = (f32x4){0.f, 0.f, 0.f, 0.f};
    bf16x8 At[4][2], B0[2][2], B1[2][2];
    const char* cA = (const char*)g.A + (size_t)cur.pm * tstep; const char* cB = (const char*)g.Bt + (size_t)cur.pn * tstep;
    S.a_ready(cur);
    PG8_STAGE(PG8_SB(0, 0), cB, voffB); PG8_STAGE(PG8_SA(0, 0), cA, voffA); PG8_STAGE(PG8_SB(0, 1), cB + hstep, voffB); PG8_STAGE(PG8_SA(0, 1), cA + hstep, voffA);
    if (wr == 1) PG8_BAR;
    PG8_WAIT_V(4); PG8_BAR;
    PG8_STAGE(PG8_SB(1, 0), cB + kstep, voffB); PG8_STAGE(PG8_SA(1, 0), cA + kstep, voffA); PG8_STAGE(PG8_SB(1, 1), cB + hstep + kstep, voffB);
    PG8_WAIT_V(6); PG8_BAR;
    PG8_STAMP();
    for (;;) {
        const bool has_next = S.next(ui + 1, nxt);
        const char* nA = has_next ? (const char*)g.A + (size_t)nxt.pm * tstep : cA; const char* nB = has_next ? (const char*)g.Bt + (size_t)nxt.pn * tstep : cB;
        for (int t = 0; t < nt; t += 2) {
            const bool last = (t == nt - 2);
            const char* a1 = cA + (size_t)(t + 1) * kstep;
            const char* a2 = last ? nA : cA + (size_t)(t + 2) * kstep; const char* b2 = last ? nB : cB + (size_t)(t + 2) * kstep;
            const char* a3 = a2 + kstep; const char* b3 = b2 + kstep;
            if (last && has_next) S.a_ready(nxt);
            PG8_LDB(B0, 0, 0); PG8_SCHED; PG8_LDA(At, 0, 0); PG8_STAGE(PG8_SA(1, 1), a1 + hstep, voffA);
            PG8_WAIT_L(8); PG8_BAR; PG8_WAIT_L(0); PG8_MMA(0, 0, At, B0); PG8_BAR; PG8_SCHED;
            PG8_LDB(B1, 0, 1); PG8_STAGE(PG8_SB(0, 0), b2, voffB);
            PG8_BAR; PG8_WAIT_L(0); PG8_MMA(0, 1, At, B1); PG8_BAR;
            PG8_LDA(At, 0, 1); PG8_STAGE(PG8_SA(0, 0), a2, voffA);
            PG8_BAR; PG8_WAIT_L(0); PG8_MMA(1, 0, At, B0); PG8_BAR; PG8_SCHED;
            PG8_STAGE(PG8_SB(0, 1), b2 + hstep, voffB);
            PG8_WAIT_V(6); PG8_BAR; PG8_MMA(1, 1, At, B1); PG8_BAR;
            PG8_LDB(B0, 1, 0); PG8_SCHED; PG8_LDA(At, 1, 0); PG8_STAGE(PG8_SA(0, 1), a2 + hstep, voffA);
            PG8_WAIT_L(8); PG8_BAR; PG8_WAIT_L(0); PG8_MMA(0, 0, At, B0); PG8_BAR; PG8_SCHED;
            PG8_LDB(B1, 1, 1); PG8_STAGE(PG8_SB(1, 0), b3, voffB);
            PG8_BAR; PG8_WAIT_L(0); PG8_MMA(0, 1, At, B1); PG8_BAR;
            PG8_LDA(At, 1, 1); PG8_STAGE(PG8_SA(1, 0), a3, voffA);
            PG8_BAR; PG8_WAIT_L(0); PG8_MMA(1, 0, At, B0); PG8_BAR; PG8_SCHED;
            PG8_STAGE(PG8_SB(1, 1), b3 + hstep, voffB);
            PG8_WAIT_V(6); PG8_BAR; PG8_MMA(1, 1, At, B1); PG8_BAR;
        }
        PG8_STAMP();
        if constexpr (!Epi::AFTER_DRAIN) { E(acc, cur, wr, wc, fr, fq); S.done(cur); }
        PG8_STAMP();
        if (!has_next) break;
#pragma unroll
        for (int a = 0; a < 2; ++a)
#pragma unroll
            for (int b = 0; b < 2; ++b)
#pragma unroll
                for (int m = 0; m < 4; ++m)
#pragma unroll
                    for (int n = 0; n < 2; ++n) acc[a][b][m][n] = (f32x4){0.f, 0.f, 0.f, 0.f};
        cur = nxt; cA = nA; cB = nB; ++ui;
    }
    PG8_WAIT_V(0);
    if (wr == 0) PG8_BAR;
    PG8_BAR;
    if constexpr (Epi::AFTER_DRAIN) { E.fused(acc, cur, wr, wc, fr, fq, lds, wid, lane); S.done(cur); }
    PG8_STAMP();
#undef PG8_STAMP
#undef PG8_SA
#undef PG8_SB
#undef PG8_STAGE
#undef PG8_LDA
#undef PG8_LDB
#undef PG8_MMA
#undef PG8_WAIT_V
#undef PG8_WAIT_L
#undef PG8_BAR
#undef PG8_SCHED
}

}

using pg8::bf16_t; using pg8::bf16x8; using pg8::f32x4; using pg8::u32x4; using pg8::Unit;
typedef float f32x16 __attribute__((ext_vector_type(16)));
typedef short s16x4 __attribute__((ext_vector_type(4)));
typedef unsigned u32x2 __attribute__((ext_vector_type(2)));

constexpr int MT = 32768, NPR = 16384, DM = 1024, DFF = 2816, NIN = 1056;
constexpr float EPS = 1e-6f;
constexpr float QSCALE = 0.10206207261596575f * 1.4426950408889634f;
constexpr size_t MiB = 1048576;
constexpr size_t W_BT1 = 0, W_BT2Q = W_BT1 + 1792 * 1024 * 2, W_BT2KV = W_BT2Q + 768 * 256 * 2, W_BTOUT = W_BT2KV + 1024 * 256 * 2, W_BTG = W_BTOUT + 1024 * 1024 * 2,
                 W_BTU = W_BTG + (size_t)DFF * 1024 * 2, W_BTD = W_BTU + (size_t)DFF * 1024 * 2, W_F1 = W_BTD + (size_t)DFF * 1024 * 2, W_F2A = W_F1 + 128 * 128 * 2, W_F2B = W_F2A + 128 * 256 * 2,
                 W_RCOS = W_F2B + 64 * 128 * 2, W_RSIN = W_RCOS + 8192 * 16 * 4, W_TW = W_RSIN + 8192 * 16 * 4, W_RX = W_TW + 8192 * 8, W_R2 = W_RX + MT * 4, W_SSP = W_R2 + MT * 4,
                 W_SS2 = W_SSP + (size_t)MT * 8 * 4, W_SS3 = W_SS2 + (size_t)MT * 16 * 4, W_KRP = W_SS3 + (size_t)MT * 16 * 4, W_BAR = W_KRP + (size_t)MT * 32 * 2, W_SMALL_END = W_BAR + 256;
static_assert(W_SMALL_END <= 32 * MiB, "small region");
constexpr size_t W_XB = 32 * MiB  , W_MIX = 96 * MiB  , W_CQ = W_MIX, W_CKV = W_MIX + 16 * MiB, W_ACT = 160 * MiB  , W_VC = W_ACT, W_AF = W_ACT,
                 W_END = 248 * MiB;
constexpr size_t O_Q = 0, O_KN = 48 * MiB, O_VV = 80 * MiB, O_GATE = 0;
constexpr int LDS_BYTES = 131072;

struct Params { const float* in[18]; float* out; unsigned char* ws; };
typedef const __attribute__((address_space(4))) Params* KP;
#define KP_OPAQUE(p) asm volatile("" : "+s"(p))

typedef __bf16 bf16x2_t __attribute__((ext_vector_type(2)));
typedef float f32x2_t __attribute__((ext_vector_type(2)));
__device__ __forceinline__ unsigned cvtpk(float lo, float hi) { f32x2_t v = {lo, hi}; bf16x2_t b = __builtin_convertvector(v, bf16x2_t); return __builtin_bit_cast(unsigned, b); }
__device__ __forceinline__ bf16_t f2bf(float f) { return (bf16_t)(cvtpk(f, 0.f) & 0xffffu); }
__device__ __forceinline__ u32x4 pack8(f32x4 a, f32x4 b) { u32x4 w; w.x = cvtpk(a[0], a[1]); w.y = cvtpk(a[2], a[3]); w.z = cvtpk(b[0], b[1]); w.w = cvtpk(b[2], b[3]); return w; }
__device__ __forceinline__ float bflo(unsigned u) { return __uint_as_float(u << 16); }
__device__ __forceinline__ float bfhi(unsigned u) { return __uint_as_float(u & 0xffff0000u); }
__device__ __forceinline__ void unpack8(u32x4 w, f32x4& a, f32x4& b) { a = (f32x4){bflo(w.x), bfhi(w.x), bflo(w.y), bfhi(w.y)}; b = (f32x4){bflo(w.z), bfhi(w.z), bflo(w.w), bfhi(w.w)}; }
__device__ __forceinline__ int tok_pos(int row) { return row < NPR ? (row & 8191) : (row & 4095); }
__device__ __forceinline__ int tok_len(int row) { return row < NPR ? 8192 : 4096; }
__device__ __forceinline__ float wave_sum(float v) { for (int o = 32; o >= 1; o >>= 1) v += __shfl_xor(v, o); return v; }

#define EPI_ARGS const f32x4 (&acc)[2][2][4][2], const Unit& u, int wr, int wc, int fr_, int fq_
#define EPI_LOCALS int t_ = threadIdx.x; asm volatile("" : "+v"(t_)); const int fr = t_ & 15, fq = (t_ >> 4) & 3;
struct Epi1 {
    static constexpr bool PERM = true, AFTER_DRAIN = false;
    const float* RX; bf16_t* CQ; bf16_t* CKV; float* SSP; bf16_t* VC; bf16_t* KRP; const float* RCOS; const float* RSIN;
    __device__ __forceinline__ void operator()(EPI_ARGS) const {
        EPI_LOCALS
        const int row0 = u.pm * 256 + wr * 64 + fr, colt = wc * 32 + 8 * fq;
        if (u.pn < 2) {
            bf16_t* dst = u.pn == 0 ? CQ : CKV;
#pragma unroll
            for (int ai = 0; ai < 2; ++ai)
#pragma unroll
                for (int m = 0; m < 4; ++m) { const int row = row0 + ai * 128 + m * 16; const float rx = RX[row]; float ss = 0.f;
#pragma unroll
                    for (int bj = 0; bj < 2; ++bj) { const f32x4 v0 = acc[ai][bj][m][0] * rx, v1 = acc[ai][bj][m][1] * rx;
                        ss += (v0[0] * v0[0] + v0[1] * v0[1]) + (v0[2] * v0[2] + v0[3] * v0[3]) + (v1[0] * v1[0] + v1[1] * v1[1]) + (v1[2] * v1[2] + v1[3] * v1[3]);
                        *(u32x4*)(dst + (unsigned)(row * 256 + bj * 128 + colt)) = pack8(v0, v1); }
                    ss += __shfl_xor(ss, 16); ss += __shfl_xor(ss, 32);
                    if (fq == 0) SSP[(unsigned)(row * 8 + u.pn * 4 + wc)] = ss; }
        } else if (u.pn < 6) {
#pragma unroll
            for (int ai = 0; ai < 2; ++ai)
#pragma unroll
                for (int m = 0; m < 4; ++m) { const int row = row0 + ai * 128 + m * 16; const float rx = RX[row];
#pragma unroll
                    for (int bj = 0; bj < 2; ++bj) *(u32x4*)(VC + (unsigned)(row * 1024 + (u.pn - 2) * 256 + bj * 128 + colt)) = pack8(acc[ai][bj][m][0] * rx, acc[ai][bj][m][1] * rx); }
        } else if (wc == 0) {
#pragma unroll
            for (int ai = 0; ai < 2; ++ai)
#pragma unroll
                for (int m = 0; m < 4; ++m) { const int row = row0 + ai * 128 + m * 16; const float rx = RX[row]; const int pos = tok_pos(row);
                    const f32x4 c4 = *(const f32x4*)(RCOS + pos * 16 + 4 * fq), s4 = *(const f32x4*)(RSIN + pos * 16 + 4 * fq);
                    const f32x4 x1 = acc[ai][0][m][0] * rx, x2 = acc[ai][0][m][1] * rx;
                    *(u32x4*)(KRP + (unsigned)(row * 32 + 8 * fq)) = pack8(x1 * c4 - x2 * s4, x2 * c4 + x1 * s4); }
        }
    }
};
struct Epi2Q {
    static constexpr bool PERM = true, AFTER_DRAIN = false;
    const float* SSP; bf16_t* Q; const float* RCOS; const float* RSIN;
    __device__ __forceinline__ void operator()(EPI_ARGS) const {
        EPI_LOCALS
        const int row0 = u.pm * 256 + wr * 64 + fr;
#pragma unroll
        for (int ai = 0; ai < 2; ++ai)
#pragma unroll
            for (int m = 0; m < 4; ++m) { const int row = row0 + ai * 128 + m * 16; const f32x4 sp = *(const f32x4*)(SSP + (unsigned)(row * 8));
                const float rq = rsqrtf(((sp[0] + sp[1]) + (sp[2] + sp[3])) * (1.0f / 256.0f) + EPS); const int pos = tok_pos(row);
#pragma unroll
                for (int bj = 0; bj < 2; ++bj) { const int G = 32 * u.pn + 16 * bj + 4 * wc + fq, head = G / 12, part = G - 12 * head;
                    f32x4 v0 = acc[ai][bj][m][0] * rq, v1 = acc[ai][bj][m][1] * rq;
                    if (part >= 8) { const int i4 = (part - 8) * 4; const f32x4 c4 = *(const f32x4*)(RCOS + pos * 16 + i4), s4 = *(const f32x4*)(RSIN + pos * 16 + i4);
                        const f32x4 o1 = v0 * c4 - v1 * s4, o2 = v1 * c4 + v0 * s4; v0 = o1; v1 = o2; }
                    *(u32x4*)(Q + (unsigned)((head * MT + row) * 96 + 8 * part)) = pack8(v0, v1); }
                asm volatile("" ::: "memory"); }
    }
};
struct Epi2KV {
    static constexpr bool PERM = true, AFTER_DRAIN = false;
    const float* SSP; bf16_t* KN; bf16_t* VV;
    __device__ __forceinline__ void operator()(EPI_ARGS) const {
        EPI_LOCALS
        const int row0 = u.pm * 256 + wr * 64 + fr; const int within = (wc & 1) * 32 + 8 * fq; bf16_t* dst = wc < 2 ? KN : VV;
#pragma unroll
        for (int ai = 0; ai < 2; ++ai)
#pragma unroll
            for (int m = 0; m < 4; ++m) { const int row = row0 + ai * 128 + m * 16; const f32x4 sp = *(const f32x4*)(SSP + (unsigned)(row * 8 + 4));
                const float rk = rsqrtf(((sp[0] + sp[1]) + (sp[2] + sp[3])) * (1.0f / 256.0f) + EPS);
#pragma unroll
                for (int bj = 0; bj < 2; ++bj) { const int head = 2 * u.pn + bj;
                    *(u32x4*)(dst + (unsigned)((head * MT + row) * 64 + within)) = pack8(acc[ai][bj][m][0] * rk, acc[ai][bj][m][1] * rk); }
                asm volatile("" ::: "memory"); }
    }
};
struct EpiSS {
    static constexpr bool PERM = true, AFTER_DRAIN = false;
    bf16_t* O; float* SS;
    __device__ __forceinline__ void operator()(EPI_ARGS) const {
        EPI_LOCALS
        const int row0 = u.pm * 256 + wr * 64 + fr, colt = u.pn * 256 + wc * 32 + 8 * fq;
#pragma unroll
        for (int ai = 0; ai < 2; ++ai)
#pragma unroll
            for (int m = 0; m < 4; ++m) { const int row = row0 + ai * 128 + m * 16; float ss = 0.f;
#pragma unroll
                for (int bj = 0; bj < 2; ++bj) { const f32x4 v0 = acc[ai][bj][m][0], v1 = acc[ai][bj][m][1];
                    ss += (v0[0] * v0[0] + v0[1] * v0[1]) + (v0[2] * v0[2] + v0[3] * v0[3]) + (v1[0] * v1[0] + v1[1] * v1[1]) + (v1[2] * v1[2] + v1[3] * v1[3]);
                    *(u32x4*)(O + (unsigned)(row * 1024 + bj * 128 + colt)) = pack8(v0, v1); }
                ss += __shfl_xor(ss, 16); ss += __shfl_xor(ss, 32);
                if (fq == 0) SS[(unsigned)(row * 16 + u.pn * 4 + wc)] = ss; }
    }
};
struct EpiGate {
    static constexpr bool PERM = true, AFTER_DRAIN = false;
    const float* R2; bf16_t* G;
    __device__ __forceinline__ void operator()(EPI_ARGS) const {
        EPI_LOCALS
        const int row0 = u.pm * 256 + wr * 64 + fr, colt = u.pn * 256 + wc * 32 + 8 * fq;
#pragma unroll
        for (int ai = 0; ai < 2; ++ai)
#pragma unroll
            for (int m = 0; m < 4; ++m) { const int row = row0 + ai * 128 + m * 16; const float r2 = R2[row];
#pragma unroll
                for (int bj = 0; bj < 2; ++bj) *(u32x4*)(G + (unsigned)(row * DFF + bj * 128 + colt)) = pack8(acc[ai][bj][m][0] * r2, acc[ai][bj][m][1] * r2); }
    }
};
__device__ __forceinline__ float gelu_t(float x) {
    const float u2 = x * (1.5957691216057308f + 0.07135481627159855f * x * x);
    return x * __builtin_amdgcn_rcpf(1.0f + __builtin_amdgcn_exp2f(-1.4426950408889634f * u2));
}
struct EpiUp {
    static constexpr bool PERM = true, AFTER_DRAIN = false;
    const float* R2; const bf16_t* G; const float* CW; const float* CB; bf16_t* ACT; int hb;
    __device__ __forceinline__ void operator()(EPI_ARGS) const {
        EPI_LOCALS
        const int row0 = u.pm * 256 + wr * 64 + fr;
#pragma unroll
        for (int bj = 0; bj < 2; ++bj) { const int col = u.pn * 256 + bj * 128 + wc * 32 + 8 * fq;
            const f32x4 w0a = *(const f32x4*)(CW + col), w0b = *(const f32x4*)(CW + col + 4), w1a = *(const f32x4*)(CW + DFF + col), w1b = *(const f32x4*)(CW + DFF + col + 4),
                        w2a = *(const f32x4*)(CW + 2 * DFF + col), w2b = *(const f32x4*)(CW + 2 * DFF + col + 4), ba = *(const f32x4*)(CB + col), bb = *(const f32x4*)(CB + col + 4);
#pragma unroll
            for (int ai = 0; ai < 2; ++ai)
#pragma unroll
                for (int m = 0; m < 4; ++m) { const int row = row0 + ai * 128 + m * 16; const int pos = tok_pos(hb + row), len = tok_len(hb + row); const float r2 = R2[row];
                    const bf16_t* gp = G + (unsigned)(row * DFF + col);
                    f32x4 g1a, g1b, g0a = {0.f, 0.f, 0.f, 0.f}, g0b = g0a, g2a = g0a, g2b = g0a;
                    unpack8(*(const u32x4*)gp, g1a, g1b);
                    if (pos > 0) unpack8(*(const u32x4*)(gp - DFF), g0a, g0b);
                    if (pos < len - 1) unpack8(*(const u32x4*)(gp + DFF), g2a, g2b);
                    const f32x4 ta = ba + w0a * g0a + w1a * g1a + w2a * g2a, tb = bb + w0b * g0b + w1b * g1b + w2b * g2b;
                    const f32x4 ua = acc[ai][bj][m][0] * r2, ub = acc[ai][bj][m][1] * r2;
                    f32x4 oa, ob;
#pragma unroll
                    for (int j = 0; j < 4; ++j) { oa[j] = gelu_t(ta[j]) * ua[j]; ob[j] = gelu_t(tb[j]) * ub[j]; }
                    *(u32x4*)(ACT + (unsigned)(row * DFF + col)) = pack8(oa, ob);
                    asm volatile("" ::: "memory"); } }
    }
};

template <class F> __device__ __forceinline__ void ttile(const F& src, bf16_t* dst, int lddst, int k0, int n0, float* tile) {
    const int tid = threadIdx.x, a = tid >> 6, b = tid & 63;
#pragma unroll
    for (int i = 0; i < 8; ++i) { const int kk = a + 8 * i; tile[kk * 65 + b] = src(k0 + kk, n0 + b); }
    __syncthreads();
    const int a2 = tid >> 5, b2 = (tid & 31) * 2;
#pragma unroll
    for (int i = 0; i < 4; ++i) { const int nn = a2 + 16 * i; *(unsigned*)(dst + (size_t)(n0 + nn) * lddst + k0 + b2) = cvtpk(tile[b2 * 65 + nn], tile[(b2 + 1) * 65 + nn]); }
    __syncthreads();
}
struct SrcPlain { const float* w; int ld; const float* g; float mul; __device__ __forceinline__ float operator()(int k, int n) const { return w[(size_t)k * ld + n] * (g ? g[k] : 1.0f) * mul; } };
struct SrcQ { const float* w; const float* g; __device__ __forceinline__ float operator()(int k, int n) const {
    const int G = n >> 3, i8 = n & 7, head = G / 12, part = G - 12 * head; int oc;
    if (part < 8) oc = head * 96 + 8 * part + i8; else { const int i = part - 8; oc = head * 96 + 64 + (i8 < 4 ? 4 * i + i8 : 16 + 4 * i + (i8 - 4)); }
    return w[(size_t)k * 768 + oc] * g[k] * QSCALE; } };
struct SrcKR { const float* w; const float* g; __device__ __forceinline__ float operator()(int k, int p) const {
    if (p >= 32) return 0.f; const int oc = 512 + ((p >> 2) & 1) * 16 + 4 * (p >> 3) + (p & 3); return w[(size_t)k * NIN + oc] * g[k]; } };
struct SrcV { const float* w; const float* g; const float* cs; __device__ __forceinline__ float operator()(int k, int n) const {
    const int chp = n >> 1, reim = n & 1, grp = chp >> 7, cp = chp & 127; const float* wr = w + (size_t)k * NIN + 544 + grp * 128; float s = 0.f;
    for (int c = 0; c < 128; ++c) s += wr[c] * cs[2 * ((c * cp) & 127) + reim];
    return s * g[k] * 0.08838834764831845f; } };
struct SrcFO { const float* wf; const float* wo; __device__ __forceinline__ float operator()(int k, int n) const {
    const int kk = k - 512, grp = kk >> 7; const float* a = wf + (size_t)kk * 128; const float* b = wo + (size_t)(512 + grp * 128) * 1024 + n; float s = 0.f;
    for (int c2 = 0; c2 < 128; ++c2) s += a[c2] * b[(size_t)c2 * 1024];
    return s; } };

__device__ __forceinline__ void phase0(KP p, unsigned char* shm) {
    int tid_ = threadIdx.x; asm volatile("" : "+v"(tid_));
    const int tid = tid_, lane = tid & 63, wid = tid >> 6, G = gridDim.x, b = blockIdx.x;
    unsigned char* ws = p->ws;
    float* tile = (float*)shm; float* cs = (float*)(shm + 64 * 65 * 4);
    if (tid < 128) { float s, c; sincospif((float)tid * (1.0f / 64.0f), &s, &c); cs[2 * tid] = c; cs[2 * tid + 1] = -s; }
    __syncthreads();
    const float *x_in = p->in[2]  , *w_in = p->in[3], *g_q = p->in[4], *w_uq = p->in[5], *g_kv = p->in[6], *w_ukv = p->in[7], *w_fnet = p->in[8], *w_out = p->in[9],
                *g_pre_ffn = p->in[11], *w_gate = p->in[12], *w_up = p->in[13], *w_down = p->in[16];
    bf16_t *BT1 = (bf16_t*)(ws + W_BT1), *BT2Q = (bf16_t*)(ws + W_BT2Q), *BT2KV = (bf16_t*)(ws + W_BT2KV), *BTOUT = (bf16_t*)(ws + W_BTOUT), *BTG = (bf16_t*)(ws + W_BTG), *BTU = (bf16_t*)(ws + W_BTU), *BTD = (bf16_t*)(ws + W_BTD);
    constexpr int J0 = 256, J1 = J0 + 128, J2 = J1 + 128, J3 = J2 + 48, J4 = J3 + 64, J5 = J4 + 128, J6 = J5 + 704, J7 = J6 + 704, J8 = J7 + 704, J9 = J8 + 64;
    for (int t = b; t < J9; t += G) {
        if (t < J0) { const int j = t; ttile(SrcV{w_in, x_in, cs}, BT1 + (size_t)512 * 1024, 1024, (j & 15) * 64, (j >> 4) * 64, tile); }
        else if (t < J1) { const int j = t - J0; ttile(SrcFO{w_fnet, w_out}, BTOUT, 1024, 512 + (j & 7) * 64, (j >> 3) * 64, tile); }
        else if (t < J2) { const int j = t - J1; ttile(SrcPlain{w_in, NIN, x_in, 1.f}, BT1, 1024, (j & 15) * 64, (j >> 4) * 64, tile); }
        else if (t < J3) { const int j = t - J2; ttile(SrcQ{w_uq, g_q}, BT2Q, 256, (j & 3) * 64, (j >> 2) * 64, tile); }
        else if (t < J4) { const int j = t - J3; ttile(SrcPlain{w_ukv, 1024, g_kv, 1.f}, BT2KV, 256, (j & 3) * 64, (j >> 2) * 64, tile); }
        else if (t < J5) { const int j = t - J4; ttile(SrcPlain{w_out, 1024, nullptr, 1.f}, BTOUT, 1024, (j & 7) * 64, (j >> 3) * 64, tile); }
        else if (t < J6) { const int j = t - J5; ttile(SrcPlain{w_gate, DFF, g_pre_ffn, 1.f}, BTG, 1024, (j & 15) * 64, (j >> 4) * 64, tile); }
        else if (t < J7) { const int j = t - J6; ttile(SrcPlain{w_up, DFF, g_pre_ffn, 1.f}, BTU, 1024, (j & 15) * 64, (j >> 4) * 64, tile); }
        else if (t < J8) { const int j = t - J7; ttile(SrcPlain{w_down, 1024, nullptr, 1.f}, BTD, DFF, (j % 44) * 64, (j / 44) * 64, tile); }
        else { const int j = t - J8; ttile(SrcKR{w_in, x_in}, BT1 + (size_t)1536 * 1024, 1024, (j & 15) * 64, (j >> 4) * 64, tile); }
    }
    { float* RCOS = (float*)(ws + W_RCOS); float* RSIN = (float*)(ws + W_RSIN); float* TW = (float*)(ws + W_TW);
      bf16_t* F1 = (bf16_t*)(ws + W_F1); bf16_t* F2A = (bf16_t*)(ws + W_F2A); bf16_t* F2B = (bf16_t*)(ws + W_F2B);
      constexpr int E0 = 8192 * 16, E1 = E0 + 8192, E2 = E1 + 128 * 128, E3 = E2 + 128 * 256, E4 = E3 + 64 * 128;
      for (int e = b * 512 + tid; e < E4; e += G * 512) {
          if (e < E0) { const int pos = e >> 4, j = e & 15; const float inv = powf(10000.0f, -(float)j * (1.0f / 16.0f)); const float ang = (float)pos * inv; float s, c; sincosf(ang, &s, &c); RCOS[e] = c; RSIN[e] = s; }
          else if (e < E1) { const int m = e - E0; float s, c; sincospif((float)m * (1.0f / 4096.0f), &s, &c); TW[2 * m] = c; TW[2 * m + 1] = s; }
          else if (e < E2) { const int i = e - E1, mm = i >> 7, kx = i & 127, k1 = mm >> 1, ro = mm & 1, n1 = kx >> 1, ri = kx & 1; float s, c; sincospif((float)((n1 * k1) & 63) * (1.0f / 32.0f), &s, &c);
              const float v = (ro == ri) ? c : (ro == 0 ? s : -s); F1[i] = f2bf(v * 0.125f); }
          else if (e < E3) { const int i = e - E2, k2 = i >> 8, kx = i & 255, n2 = kx >> 1, ri = kx & 1; float s, c; sincospif((float)((n2 * k2) & 127) * (1.0f / 64.0f), &s, &c); F2A[i] = f2bf((ri ? s : c) * 0.08838834764831845f); }
          else { const int i = e - E3, k2 = i >> 7, kx = i & 127, n2 = kx >> 1, ri = kx & 1; float s, c; sincospif((float)((n2 * k2) & 63) * (1.0f / 32.0f), &s, &c); F2B[i] = f2bf((ri ? s : c) * 0.125f); }
      } }
    { bf16_t* XB = (bf16_t*)(ws + W_XB); float* RX = (float*)(ws + W_RX);
      for (int row = b * 8 + wid; row < MT; row += G * 8) {
          const float* xr = row < NPR ? p->in[0] + (size_t)row * DM : p->in[1] + (size_t)(row - NPR) * DM;
          f32x4 v[4]; float ss = 0.f;
#pragma unroll
          for (int j = 0; j < 4; ++j) { v[j] = *(const f32x4*)(xr + j * 256 + lane * 4); ss += (v[j][0] * v[j][0] + v[j][1] * v[j][1]) + (v[j][2] * v[j][2] + v[j][3] * v[j][3]); }
          ss = wave_sum(ss);
          if (lane == 0) RX[row] = rsqrtf(ss * (1.0f / 1024.0f) + EPS);
#pragma unroll
          for (int j = 0; j < 4; ++j) { u32x2 w; w.x = cvtpk(v[j][0], v[j][1]); w.y = cvtpk(v[j][2], v[j][3]); *(u32x2*)(XB + (size_t)row * DM + j * 256 + lane * 4) = w; }
      } }
}

__device__ __forceinline__ void load_x1(KP p, const unsigned char* ws, int row, int lane, const f32x4 (&gpm)[4], f32x4 (&x1)[4]) {
    const float* xr = row < NPR ? p->in[0] + (size_t)row * DM : p->in[1] + (size_t)(row - NPR) * DM;
    const bf16_t* mr = (const bf16_t*)(ws + W_MIX) + (size_t)row * DM; const float* ssp = (const float*)(ws + W_SS2) + (size_t)row * 16;
    const f32x4 s0 = *(const f32x4*)ssp, s1 = *(const f32x4*)(ssp + 4), s2 = *(const f32x4*)(ssp + 8), s3 = *(const f32x4*)(ssp + 12); const f32x4 st = (s0 + s1) + (s2 + s3);
    const float rm = rsqrtf(((st[0] + st[1]) + (st[2] + st[3])) * (1.0f / 1024.0f) + EPS);
#pragma unroll
    for (int j = 0; j < 4; ++j) { const f32x4 xv = *(const f32x4*)(xr + j * 256 + lane * 4); const u32x2 mw = *(const u32x2*)(mr + j * 256 + lane * 4);
        const f32x4 mv = {bflo(mw.x), bfhi(mw.x), bflo(mw.y), bfhi(mw.y)}; x1[j] = xv + mv * rm * gpm[j]; }
}
__device__ __forceinline__ void phase5(KP p) {
    int tid_ = threadIdx.x; asm volatile("" : "+v"(tid_));
    const int tid = tid_, lane = tid & 63, wid = tid >> 6, G = gridDim.x, b = blockIdx.x; unsigned char* ws = p->ws;
    f32x4 gpm[4];
#pragma unroll
    for (int j = 0; j < 4; ++j) gpm[j] = *(const f32x4*)(p->in[10] + j * 256 + lane * 4);
    bf16_t* XB1 = (bf16_t*)(ws + W_XB); float* R2 = (float*)(ws + W_R2);
    for (int row = b * 8 + wid; row < MT; row += G * 8) {
        f32x4 x1[4]; load_x1(p, ws, row, lane, gpm, x1); float ss = 0.f;
#pragma unroll
        for (int j = 0; j < 4; ++j) ss += (x1[j][0] * x1[j][0] + x1[j][1] * x1[j][1]) + (x1[j][2] * x1[j][2] + x1[j][3] * x1[j][3]);
        ss = wave_sum(ss);
        if (lane == 0) R2[row] = rsqrtf(ss * (1.0f / 1024.0f) + EPS);
#pragma unroll
        for (int j = 0; j < 4; ++j) { u32x2 w; w.x = cvtpk(x1[j][0], x1[j][1]); w.y = cvtpk(x1[j][2], x1[j][3]); *(u32x2*)(XB1 + (size_t)row * DM + j * 256 + lane * 4) = w; }
    }
}
__device__ __forceinline__ void phase9(KP p) {
    int tid_ = threadIdx.x; asm volatile("" : "+v"(tid_));
    const int tid = tid_, lane = tid & 63, wid = tid >> 6, G = gridDim.x, b = blockIdx.x; unsigned char* ws = p->ws;
    f32x4 gpm[4], gpf[4];
#pragma unroll
    for (int j = 0; j < 4; ++j) { gpm[j] = *(const f32x4*)(p->in[10] + j * 256 + lane * 4); gpf[j] = *(const f32x4*)(p->in[17] + j * 256 + lane * 4); }
    const bf16_t* FFN = (const bf16_t*)(ws + W_XB); const float* SS3 = (const float*)(ws + W_SS3);
    for (int row = b * 8 + wid; row < MT; row += G * 8) {
        f32x4 x1[4]; load_x1(p, ws, row, lane, gpm, x1);
        const float* ssp = SS3 + (size_t)row * 16; const f32x4 s0 = *(const f32x4*)ssp, s1 = *(const f32x4*)(ssp + 4), s2 = *(const f32x4*)(ssp + 8), s3 = *(const f32x4*)(ssp + 12); const f32x4 st = (s0 + s1) + (s2 + s3);
        const float rf = rsqrtf(((st[0] + st[1]) + (st[2] + st[3])) * (1.0f / 1024.0f) + EPS);
#pragma unroll
        for (int j = 0; j < 4; ++j) { const u32x2 fw = *(const u32x2*)(FFN + (size_t)row * DM + j * 256 + lane * 4); const f32x4 fv = {bflo(fw.x), bfhi(fw.x), bflo(fw.y), bfhi(fw.y)};
            *(f32x4*)(p->out + (size_t)row * DM + j * 256 + lane * 4) = x1[j] + fv * rf * gpf[j]; }
    }
}

__device__ __forceinline__ int crow(int r, int hi) { return (r & 3) + 8 * (r >> 2) + 4 * hi; }
__device__ __forceinline__ bf16x8 ldsB(const unsigned* T, int r0, int n) { u32x4 w = {T[(r0 + 0) * 128 + n], T[(r0 + 1) * 128 + n], T[(r0 + 2) * 128 + n], T[(r0 + 3) * 128 + n]}; return *reinterpret_cast<bf16x8*>(&w); }
__device__ __forceinline__ void fft_stage1(KP p, unsigned char* shm) {
    int tid_ = threadIdx.x; asm volatile("" : "+v"(tid_));
    const int tid = tid_, lane = tid & 63, wid = __builtin_amdgcn_readfirstlane(tid >> 6), l32 = lane & 31, hi = lane >> 5, G = gridDim.x; unsigned char* ws = p->ws;
    const unsigned* VC = (const unsigned*)(ws + W_VC); unsigned* T1 = (unsigned*)(ws + W_XB); const bf16_t* F1 = (const bf16_t*)(ws + W_F1); const float* TW = (const float*)(ws + W_TW);
    unsigned* T = (unsigned*)shm;
    const int mb = wid & 3, cb0 = (wid >> 2) * 2;
    bf16x8 a[8];
#pragma unroll
    for (int ks = 0; ks < 8; ++ks) a[ks] = *(const bf16x8*)(F1 + (32 * mb + l32) * 128 + 16 * ks + 8 * hi);
    for (int it = blockIdx.x; it < 2048; it += G) {
        const int chb = it & 3, sn = it >> 2; int seqbase, N2, n2, tws;
        if (sn < 256) { seqbase = (sn >> 7) * 8192; N2 = 128; n2 = sn & 127; tws = 1; } else { const int s2 = sn - 256; seqbase = NPR + (s2 >> 6) * 4096; N2 = 64; n2 = s2 & 63; tws = 2; }
        __syncthreads();
#pragma unroll
        for (int i = 0; i < 4; ++i) { const int idx = tid + 512 * i, r = idx >> 5, c4 = idx & 31;
            *(u32x4*)(T + r * 128 + c4 * 4) = *(const u32x4*)(VC + (size_t)(seqbase + N2 * r + n2) * 512 + chb * 128 + c4 * 4); }
        __syncthreads();
#pragma unroll
        for (int c = 0; c < 2; ++c) { const int n = 32 * (cb0 + c) + l32; f32x16 acc = {};
#pragma unroll
            for (int ks = 0; ks < 8; ++ks) acc = __builtin_amdgcn_mfma_f32_32x32x16_bf16(a[ks], ldsB(T, 8 * ks + 4 * hi, n), acc, 0, 0, 0);
#pragma unroll
            for (int q = 0; q < 4; ++q)
#pragma unroll
                for (int e = 0; e < 2; ++e) { const int k1 = 16 * mb + 4 * q + 2 * hi + e; const float re = acc[4 * q + 2 * e], im = acc[4 * q + 2 * e + 1];
                    const int ti = (n2 * k1 * tws) & 8191; const float cc = TW[2 * ti], sn_ = TW[2 * ti + 1];
                    T1[(size_t)(seqbase + k1 * N2 + n2) * 512 + chb * 128 + n] = cvtpk(re * cc + im * sn_, im * cc - re * sn_); } }
    }
    __syncthreads();
}
template <int N2> __device__ __forceinline__ void fft_stage2_item(KP p, unsigned* T, int seqbase, int k1, int chb, int tid, int wid, int l32, int hi) {
    unsigned char* ws = p->ws; const unsigned* T1 = (const unsigned*)(ws + W_XB); bf16_t* AF = (bf16_t*)(ws + W_AF);
    const bf16_t* F2 = (const bf16_t*)(ws + (N2 == 128 ? W_F2A : W_F2B));
#pragma unroll
    for (int i = 0; i < N2 / 16; ++i) { const int idx = tid + 512 * i, r = idx >> 5, c4 = idx & 31;
        *(u32x4*)(T + r * 128 + c4 * 4) = *(const u32x4*)(T1 + (size_t)(seqbase + k1 * N2 + r) * 512 + chb * 128 + c4 * 4); }
    __syncthreads();
    constexpr int NMB = N2 / 32, NCB = (N2 == 128) ? 2 : 1, KS = N2 / 8;
    const int mb = wid & (NMB - 1), cbase = (N2 == 128) ? (wid >> 2) * 2 : (wid >> 1);
#pragma unroll
    for (int c = 0; c < NCB; ++c) { const int n = 32 * (cbase + c) + l32; f32x16 acc = {};
#pragma unroll
        for (int ks = 0; ks < KS; ++ks) { const bf16x8 a = *(const bf16x8*)(F2 + (32 * mb + l32) * (2 * N2) + 16 * ks + 8 * hi);
            acc = __builtin_amdgcn_mfma_f32_32x32x16_bf16(a, ldsB(T, 8 * ks + 4 * hi, n), acc, 0, 0, 0); }
#pragma unroll
        for (int r = 0; r < 16; ++r) { const int k2 = 32 * mb + crow(r, hi); AF[(size_t)(seqbase + k1 + 64 * k2) * 1024 + 512 + chb * 128 + n] = f2bf(acc[r]); } }
    __syncthreads();
}
__device__ __forceinline__ void fft_stage2(KP p, unsigned char* shm) {
    int tid_ = threadIdx.x; asm volatile("" : "+v"(tid_));
    const int tid = tid_, lane = tid & 63, wid = __builtin_amdgcn_readfirstlane(tid >> 6), l32 = lane & 31, hi = lane >> 5, G = gridDim.x;
    unsigned* T = (unsigned*)shm;
    __syncthreads();
    for (int it = blockIdx.x; it < 1536; it += G) { const int chb = it & 3, k1 = (it >> 2) & 63, seq = it >> 8;
        if (seq < 2) fft_stage2_item<128>(p, T, seq * 8192, k1, chb, tid, wid, l32, hi);
        else fft_stage2_item<64>(p, T, NPR + (seq - 2) * 4096, k1, chb, tid, wid, l32, hi); }
}

namespace att {
constexpr int KVBLK = 64, SHM_V = 8192, SHM_K = 16384;
constexpr float THRL = 11.5f;
#define KSWZ(row, colB) ((row) * 256 + ((colB) ^ (((row) & 7) << 4)))
#define SBAR() __builtin_amdgcn_sched_barrier(0)
__device__ __forceinline__ void partialSM(f32x16& p0, f32x16& p1, float& m_reg, float& mn, float& alpha) {
    float pmax = p0[0];
#pragma unroll
    for (int r = 1; r < 16; ++r) pmax = fmaxf(pmax, p0[r]);
#pragma unroll
    for (int r = 0; r < 16; ++r) pmax = fmaxf(pmax, p1[r]);
    { auto rr = __builtin_amdgcn_permlane32_swap(__float_as_uint(pmax), __float_as_uint(pmax), false, false); pmax = fmaxf(__uint_as_float(rr[0]), __uint_as_float(rr[1])); }
    if (__builtin_expect(__all(pmax - m_reg <= THRL), 1)) { mn = m_reg; alpha = 1.f; }
    else { mn = fmaxf(m_reg, pmax); alpha = __builtin_amdgcn_exp2f(m_reg - mn); m_reg = mn; }
#pragma unroll
    for (int r = 0; r < 16; ++r) p0[r] = p0[r] - mn;
#pragma unroll
    for (int r = 0; r < 16; ++r) p1[r] = p1[r] - mn;
#pragma unroll
    for (int r = 0; r < 16; ++r) p0[r] = __builtin_amdgcn_exp2f(p0[r]);
}
__device__ __forceinline__ void finishSM(f32x16& p0, f32x16& p1, float alpha, float& l_reg, bf16x8& pa0, bf16x8& pa1, bf16x8& pa2, bf16x8& pa3) {
#pragma unroll
    for (int r = 0; r < 16; ++r) p1[r] = __builtin_amdgcn_exp2f(p1[r]);
    float ps = 0;
#pragma unroll
    for (int r = 0; r < 16; ++r) ps += p0[r];
#pragma unroll
    for (int r = 0; r < 16; ++r) ps += p1[r];
    { auto rr = __builtin_amdgcn_permlane32_swap(__float_as_uint(ps), __float_as_uint(ps), false, false); ps = __uint_as_float(rr[0]) + __uint_as_float(rr[1]); }
    l_reg = l_reg * alpha + ps;
#define PK4(P, BASE, OUT) do { unsigned a0 = cvtpk(P[BASE + 0], P[BASE + 1]), a1 = cvtpk(P[BASE + 2], P[BASE + 3]);   \
    unsigned b0 = cvtpk(P[BASE + 4], P[BASE + 5]), b1 = cvtpk(P[BASE + 6], P[BASE + 7]);                              \
    auto r0 = __builtin_amdgcn_permlane32_swap(a0, b0, false, false); auto r1 = __builtin_amdgcn_permlane32_swap(a1, b1, false, false); \
    u32x4 w = {r0[0], r1[0], r0[1], r1[1]}; OUT = *reinterpret_cast<bf16x8*>(&w); } while (0)
    PK4(p0, 0, pa0); PK4(p0, 8, pa1); PK4(p1, 0, pa2); PK4(p1, 8, pa3);
#undef PK4
}
__device__ __forceinline__ void qkt(f32x16& p0, f32x16& p1, const char* Ks, const bf16x8* qr, int r32, int hi) {
    p0 = f32x16{}; p1 = f32x16{};
#pragma unroll
    for (int d0 = 0; d0 < 6; ++d0) { const int cb = (d0 * 16 + hi * 8) * 2;
        bf16x8 b0 = *reinterpret_cast<const bf16x8*>(Ks + KSWZ(r32, cb));
        bf16x8 b1 = *reinterpret_cast<const bf16x8*>(Ks + KSWZ(32 + r32, cb));
        p0 = __builtin_amdgcn_mfma_f32_32x32x16_bf16(b0, qr[d0], p0, 0, 0, 0);
        p1 = __builtin_amdgcn_mfma_f32_32x32x16_bf16(b1, qr[d0], p1, 0, 0, 0); }
}
__device__ __forceinline__ int v_st(int k, int c) { const int kk = (k & ~0xC) | ((k & 4) << 1) | ((k & 8) >> 1); return ((kk >> 3) * 2 + (c >> 5)) * 512 + ((kk & 7) * 32 + (c & 31)) * 2; }
__device__ __forceinline__ int v_rd_base(int lane) { return ((lane & 3) << 3) | (((lane >> 2) & 3) << 6) | (((lane >> 4) & 1) << 5) | (((lane >> 5) & 1) << 8); }
constexpr int v_rd_off(int d0, int ks, int half) { return d0 * 512 + ks * 2048 + half * 1024; }
template <int OFF> __device__ __forceinline__ s16x4 tr_read(int vb) { s16x4 r; asm volatile("ds_read_b64_tr_b16 %0, %1 offset:%2" : "=&v"(r) : "v"(vb), "i"(OFF) : "memory"); return r; }
template <int D0> __device__ __forceinline__ void pv_one(f32x16& od, int vb, bf16x8 pa0, bf16x8 pa1, bf16x8 pa2, bf16x8 pa3) {
    const s16x4 l0 = tr_read<v_rd_off(D0, 0, 0)>(vb), h0 = tr_read<v_rd_off(D0, 0, 1)>(vb), l1 = tr_read<v_rd_off(D0, 1, 0)>(vb), h1 = tr_read<v_rd_off(D0, 1, 1)>(vb);
    const s16x4 l2 = tr_read<v_rd_off(D0, 2, 0)>(vb), h2 = tr_read<v_rd_off(D0, 2, 1)>(vb), l3 = tr_read<v_rd_off(D0, 3, 0)>(vb), h3 = tr_read<v_rd_off(D0, 3, 1)>(vb);
    asm volatile("s_waitcnt lgkmcnt(0)" ::: "memory"); SBAR();
#define PK(L, H) (bf16x8){L[0], L[1], L[2], L[3], H[0], H[1], H[2], H[3]}
    od = __builtin_amdgcn_mfma_f32_32x32x16_bf16(pa0, PK(l0, h0), od, 0, 0, 0);
    od = __builtin_amdgcn_mfma_f32_32x32x16_bf16(pa1, PK(l1, h1), od, 0, 0, 0);
    od = __builtin_amdgcn_mfma_f32_32x32x16_bf16(pa2, PK(l2, h2), od, 0, 0, 0);
    od = __builtin_amdgcn_mfma_f32_32x32x16_bf16(pa3, PK(l3, h3), od, 0, 0, 0);
#undef PK
}
__device__ __forceinline__ void pv_d0(f32x16* o, int vb, bf16x8 pa0, bf16x8 pa1, bf16x8 pa2, bf16x8 pa3) { pv_one<0>(o[0], vb, pa0, pa1, pa2, pa3); pv_one<1>(o[1], vb, pa0, pa1, pa2, pa3); }

__device__ __forceinline__ void body(const bf16_t* __restrict__ Qb, const bf16_t* __restrict__ KNh, const bf16_t* __restrict__ KRs, const bf16_t* __restrict__ Vh, bf16_t* __restrict__ Ob, int seq, char* lds) {
    int tid_ = threadIdx.x; asm volatile("" : "+v"(tid_));
    const int tid = tid_, wid = __builtin_amdgcn_readfirstlane(tid >> 6), lane = tid & 63, r32 = lane & 31, hi = lane >> 5;
    char* V_lds = lds; char* K_lds = lds + 2 * SHM_V;
    float* wsf = (float*)(lds + 2 * SHM_V + 2 * SHM_K) + wid * 64; float* li_l = wsf; float* al_l = wsf + 32;
    float m_reg = -1e30f, l_reg = 0; f32x16 o[2] = {}; bf16x8 qr[6];
    const bf16_t* Qw = Qb + (size_t)(wid * 32 + r32) * 96 + hi * 8;
#pragma unroll
    for (int d0 = 0; d0 < 6; ++d0) qr[d0] = *(const bf16x8*)(Qw + d0 * 16);
    const int vr = tid >> 3, vc = (tid & 7) * 8, vst = v_st(vr, vc);
    const char* vp = (const char*)(Vh + (size_t)vr * 64 + vc);
    const int cA = tid, rA = cA / 12, pA = cA - rA * 12; const int cB = 512 + (tid & 255), rB = cB / 12, pB = cB - rB * 12;
    const char* kpA = pA < 8 ? (const char*)(KNh + (size_t)rA * 64 + pA * 8) : (const char*)(KRs + (size_t)rA * 32 + (pA - 8) * 8); const size_t ksA = pA < 8 ? 8192 : 4096; const int kdA = KSWZ(rA, pA * 16);
    const char* kpB = pB < 8 ? (const char*)(KNh + (size_t)rB * 64 + pB * 8) : (const char*)(KRs + (size_t)rB * 32 + (pB - 8) * 8); const size_t ksB = pB < 8 ? 8192 : 4096; const int kdB = KSWZ(rB, pB * 16);
    const bool hasB = wid < 4;
    const int vb0 = (int)(uintptr_t)V_lds + v_rd_base(lane);
    struct { bf16x8 vs, ka, kb; } sr_[2];
#define SLOAD(i, j) do { sr_[i].vs = *(const bf16x8*)(vp + (size_t)(j) * 8192); sr_[i].ka = *(const bf16x8*)(kpA + (size_t)(j) * ksA); if (hasB) sr_[i].kb = *(const bf16x8*)(kpB + (size_t)(j) * ksB); } while (0)
#define SWRITE(b, i) do { *(bf16x8*)(V_lds + (b) * SHM_V + vst) = sr_[i].vs; *(bf16x8*)(K_lds + (b) * SHM_K + kdA) = sr_[i].ka; if (hasB) *(bf16x8*)(K_lds + (b) * SHM_K + kdB) = sr_[i].kb; } while (0)
#define RESC(a) do { if (__any((a) < 1.f)) { if (hi == 0) al_l[r32] = (a); asm volatile("s_waitcnt lgkmcnt(0)" ::: "memory"); \
    _Pragma("unroll") for (int d = 0; d < 2; ++d) _Pragma("unroll") for (int r = 0; r < 16; ++r) o[d][r] *= al_l[crow(r, hi)]; } } while (0)
    f32x16 pA0, pA1, pB0, pB1; float mnA, mnB, alA, alB; bf16x8 pa0, pa1, pa2, pa3; const int NT = seq / KVBLK;
    constexpr int SE = 0, SO = 1;
    __syncthreads();
    SLOAD(SE, 0); asm volatile("s_waitcnt vmcnt(0)" ::: "memory"); SWRITE(0, SE); __syncthreads();
    qkt(pA0, pA1, K_lds, qr, r32, hi); partialSM(pA0, pA1, m_reg, mnA, alA);
    SLOAD(SO, 1); if (2 < NT) SLOAD(SE, 2);
    SWRITE(1, SO); __syncthreads();
    for (int j = 1; j + 1 < NT; j += 2) {
        SBAR(); qkt(pB0, pB1, K_lds + SHM_K, qr, r32, hi);
        finishSM(pA0, pA1, alA, l_reg, pa0, pa1, pa2, pa3); SBAR();
        SLOAD(SO, j + 2); SBAR();
        pv_d0(o, vb0, pa0, pa1, pa2, pa3); partialSM(pB0, pB1, m_reg, mnB, alB);
        __syncthreads(); SWRITE(0, SE);
        RESC(alB); __syncthreads();
        SBAR(); qkt(pA0, pA1, K_lds, qr, r32, hi);
        finishSM(pB0, pB1, alB, l_reg, pa0, pa1, pa2, pa3); SBAR();
        if (j + 3 < NT) SLOAD(SE, j + 3); SBAR();
        pv_d0(o, vb0 + SHM_V, pa0, pa1, pa2, pa3); partialSM(pA0, pA1, m_reg, mnA, alA);
        __syncthreads(); SWRITE(1, SO);
        RESC(alA); __syncthreads();
    }
    SBAR(); qkt(pB0, pB1, K_lds + SHM_K, qr, r32, hi);
    finishSM(pA0, pA1, alA, l_reg, pa0, pa1, pa2, pa3); SBAR();
    pv_d0(o, vb0, pa0, pa1, pa2, pa3); partialSM(pB0, pB1, m_reg, mnB, alB);
    __syncthreads(); RESC(alB);
    finishSM(pB0, pB1, alB, l_reg, pa0, pa1, pa2, pa3); SBAR();
    pv_d0(o, vb0 + SHM_V, pa0, pa1, pa2, pa3);
    if (hi == 0) li_l[r32] = l_reg; asm volatile("s_waitcnt lgkmcnt(0)" ::: "memory");
    float rli[16];
#pragma unroll
    for (int r = 0; r < 16; ++r) rli[r] = __builtin_amdgcn_rcpf(li_l[crow(r, hi)]);
    bf16_t* Ow = Ob + (size_t)(wid * 32) * 1024;
#pragma unroll
    for (int r = 0; r < 16; ++r) { const int orow = crow(r, hi);
#pragma unroll
        for (int d0 = 0; d0 < 2; ++d0) Ow[(size_t)orow * 1024 + d0 * 32 + r32] = f2bf(o[d0][r] * rli[r]); }
#undef SLOAD
#undef SWRITE
#undef RESC
}
}

__device__ __forceinline__ void attn_phase(KP p, unsigned char* shm) {
    const int G = gridDim.x, b = blockIdx.x; unsigned char* ws = p->ws; unsigned char* od = (unsigned char*)p->out;
    const bf16_t* Q = (const bf16_t*)(od + O_Q); const bf16_t* KN = (const bf16_t*)(od + O_KN); const bf16_t* VV = (const bf16_t*)(od + O_VV); const bf16_t* KRP = (const bf16_t*)(ws + W_KRP); bf16_t* AF = (bf16_t*)(ws + W_AF);
    for (int it = b; it < 1024; it += G) {
        int pair, qb, seqbase, len, head;
        if (G == 256) { const int j = it >> 8, xcd = b & 7, slot = b >> 3;
            if (j < 2) { pair = j * 8 + xcd; qb = slot; seqbase = (pair >> 3) * 8192; len = 8192; }
            else { pair = (j - 2) * 16 + 2 * xcd + (slot >> 4); qb = slot & 15; seqbase = NPR + (pair >> 3) * 4096; len = 4096; }
        } else if (it < 512) { pair = it >> 5; qb = it & 31; seqbase = (pair >> 3) * 8192; len = 8192; }
        else { const int i2 = it - 512; pair = i2 >> 4; qb = i2 & 15; seqbase = NPR + (pair >> 3) * 4096; len = 4096; }
        head = pair & 7;
        att::body(Q + ((size_t)head * MT + seqbase + qb * 256) * 96, KN + ((size_t)head * MT + seqbase) * 64, KRP + (size_t)seqbase * 32, VV + ((size_t)head * MT + seqbase) * 64,
                  AF + (size_t)(seqbase + qb * 256) * 1024 + head * 64, len, (char*)shm);
    }
}


#ifndef DBG_STOP
#define DBG_STOP 0
#endif
__device__ __forceinline__ float bfv(const bf16_t* p, size_t i) { return __uint_as_float(((unsigned)p[i]) << 16); }
__device__ __forceinline__ void dbg_probe(KP p, int k) {
    unsigned char* ws = p->ws; float* out = p->out; const size_t n = (size_t)MT * DM;
    for (size_t i = (size_t)blockIdx.x * 512 + threadIdx.x; i < n; i += (size_t)gridDim.x * 512) { const size_t row = i >> 10; const int c = (int)(i & 1023); float v = 0.f;
        if (k == 1) v = bfv((const bf16_t*)(ws + W_VC), i) + bfv((const bf16_t*)(ws + W_CQ), row * 256 + (c & 255)) + bfv((const bf16_t*)(ws + W_CKV), row * 256 + (c & 255)) + bfv((const bf16_t*)(ws + W_KRP), row * 32 + (c & 31)) + ((const float*)(ws + W_SSP))[row * 8 + (c & 7)];
        if (k == 10) v = bfv((const bf16_t*)(ws + W_XB), i) + ((const float*)(ws + W_RX))[row];
        if (k == 11) v = bfv((const bf16_t*)(ws + W_BT1), i) + bfv((const bf16_t*)(ws + W_BTOUT), i) + bfv((const bf16_t*)(ws + W_BTG), i % ((size_t)DFF * 1024)) + bfv((const bf16_t*)(ws + W_BTD), i % ((size_t)DFF * 1024)) + bfv((const bf16_t*)(ws + W_BT2Q), i % (768 * 256)) + ((const float*)(ws + W_RCOS))[i % (8192 * 16)] + ((const float*)(ws + W_TW))[i % 16384] + bfv((const bf16_t*)(ws + W_F2A), i % 32768);
        if (k == 2) v = bfv((const bf16_t*)(ws + W_XB), i);
        if (k == 3) v = bfv((const bf16_t*)(ws + W_AF), i);
        if (k == 4) v = bfv((const bf16_t*)(ws + W_MIX), i) + ((const float*)(ws + W_SS2))[row * 16 + (c & 15)];
        if (k == 5) v = bfv((const bf16_t*)(ws + W_XB), i) + ((const float*)(ws + W_R2))[row];
        if (k == 8) v = bfv((const bf16_t*)(ws + W_XB), i) + ((const float*)(ws + W_SS3))[row * 16 + (c & 15)];
        out[i] = v; }
}
__device__ __forceinline__ void dbg_probe_qkv(KP p, int step) {
    unsigned char* ws = p->ws; float* out = p->out; const size_t n = (size_t)MT * DM; float* tmp = (float*)(ws + 96 * MiB); const unsigned char* od = (const unsigned char*)p->out;
    for (size_t i = (size_t)blockIdx.x * 512 + threadIdx.x; i < n; i += (size_t)gridDim.x * 512) {
        if (step == 0) { float v = bfv((const bf16_t*)od, i); if (i < (size_t)24 * 1048576) v += bfv((const bf16_t*)(od + 64 * MiB), i); tmp[i] = v; }
        else out[i] = tmp[i]; }
}
#ifndef PHM
#define PHM 0xFFFF
#endif
#define PH(n) if constexpr ((PHM >> (n)) & 1)
__global__ void __launch_bounds__(512) mega_fwd(Params p_unused) {
    extern __shared__ __attribute__((aligned(16))) unsigned char shm[];
    cg::grid_group grid = cg::this_grid();
    PG8_LAS unsigned char* lds = (PG8_LAS unsigned char*)shm;
    const int G = gridDim.x, b = blockIdx.x;
    KP p = (KP)__builtin_amdgcn_kernarg_segment_ptr();

#ifndef OWN_BAR
#define OWN_BAR 1
#endif
#if OWN_BAR
#define GRID_SYNC(gen) do { asm volatile("s_waitcnt vmcnt(0) lgkmcnt(0)" ::: "memory"); __syncthreads(); \
        if (threadIdx.x == 0) { unsigned* cnt = (unsigned*)(p->ws + W_BAR); __builtin_amdgcn_fence(__ATOMIC_RELEASE, "agent"); asm volatile("s_waitcnt vmcnt(0)" ::: "memory"); \
            const unsigned target = (unsigned)(gen) * (unsigned)gridDim.x; __hip_atomic_fetch_add(cnt, 1u, __ATOMIC_RELAXED, __HIP_MEMORY_SCOPE_AGENT); \
            while (__hip_atomic_load(cnt, __ATOMIC_RELAXED, __HIP_MEMORY_SCOPE_AGENT) < target) __builtin_amdgcn_s_sleep(1); } \
        __syncthreads(); __builtin_amdgcn_fence(__ATOMIC_ACQUIRE, "agent"); asm volatile("s_waitcnt vmcnt(0)" ::: "memory"); } while (0)
    grid.sync();
#else
#define GRID_SYNC(gen) do { asm volatile("s_waitcnt vmcnt(0) lgkmcnt(0)" ::: "memory"); grid.sync(); __builtin_amdgcn_fence(__ATOMIC_ACQUIRE, "agent"); asm volatile("s_waitcnt vmcnt(0)" ::: "memory"); } while (0)
#endif
    PH(0) phase0(p, shm);
    GRID_SYNC(1);
    if constexpr (DBG_STOP == 10 || DBG_STOP == 11) { dbg_probe(p, DBG_STOP); return; }
    PH(1) {
        KP_OPAQUE(p); unsigned char* ws = p->ws;
        pg8::Gemm g{(const bf16_t*)(ws + W_XB), (const bf16_t*)(ws + W_BT1), MT, 1792, 1024}; pg8::StaticOrder S; S.init(MT, 1792, G, b);
        Epi1 E{(const float*)(ws + W_RX), (bf16_t*)(ws + W_CQ), (bf16_t*)(ws + W_CKV), (float*)(ws + W_SSP), (bf16_t*)(ws + W_VC), (bf16_t*)(ws + W_KRP), (const float*)(ws + W_RCOS), (const float*)(ws + W_RSIN)};
        pg8::gemm_phase<Epi1, pg8::StaticOrder>(lds, g, S, E);
    }
    GRID_SYNC(2);
    if constexpr (DBG_STOP == 1) { dbg_probe(p, 1); return; }
    {
        PH(2) { KP_OPAQUE(p); unsigned char* ws = p->ws; unsigned char* od = (unsigned char*)p->out;
          pg8::Gemm g{(const bf16_t*)(ws + W_CQ), (const bf16_t*)(ws + W_BT2Q), MT, 768, 256}; pg8::StaticOrder S; S.init(MT, 768, G, b);
          Epi2Q E{(const float*)(ws + W_SSP), (bf16_t*)(od + O_Q), (const float*)(ws + W_RCOS), (const float*)(ws + W_RSIN)}; pg8::gemm_phase<Epi2Q, pg8::StaticOrder>(lds, g, S, E); }
        PH(3) { KP_OPAQUE(p); unsigned char* ws = p->ws; unsigned char* od = (unsigned char*)p->out;
          pg8::Gemm g{(const bf16_t*)(ws + W_CKV), (const bf16_t*)(ws + W_BT2KV), MT, 1024, 256}; pg8::StaticOrder S; S.init(MT, 1024, G, b);
          Epi2KV E{(const float*)(ws + W_SSP), (bf16_t*)(od + O_KN), (bf16_t*)(od + O_VV)}; pg8::gemm_phase<Epi2KV, pg8::StaticOrder>(lds, g, S, E); }
        PH(4) { KP_OPAQUE(p); fft_stage1(p, shm); }
    }
    GRID_SYNC(3);
    if constexpr (DBG_STOP == 2) { dbg_probe(p, 2); return; }
    if constexpr (DBG_STOP == 20) { dbg_probe_qkv(p, 0); GRID_SYNC(4); dbg_probe_qkv(p, 1); return; }
    PH(5) { KP_OPAQUE(p); attn_phase(p, shm); }
    PH(6) { KP_OPAQUE(p); fft_stage2(p, shm); }
    GRID_SYNC(4);
    if constexpr (DBG_STOP == 3) { dbg_probe(p, 3); return; }
    PH(7) {
        KP_OPAQUE(p); unsigned char* ws = p->ws;
        pg8::Gemm g{(const bf16_t*)(ws + W_AF), (const bf16_t*)(ws + W_BTOUT), MT, 1024, 1024}; pg8::StaticOrder S; S.init(MT, 1024, G, b);
        EpiSS E{(bf16_t*)(ws + W_MIX), (float*)(ws + W_SS2)}; pg8::gemm_phase<EpiSS, pg8::StaticOrder>(lds, g, S, E);
    }
    GRID_SYNC(5);
    if constexpr (DBG_STOP == 4) { dbg_probe(p, 4); return; }
    PH(8) { KP_OPAQUE(p); phase5(p); }
    GRID_SYNC(6);
    if constexpr (DBG_STOP == 5) { dbg_probe(p, 5); return; }
#pragma unroll 1
    for (int h = 0; h < 2; ++h) { const int hb = h * NPR;
        PH(9) { KP_OPAQUE(p); unsigned char* ws = p->ws; unsigned char* od = (unsigned char*)p->out; const bf16_t* XB1h = (const bf16_t*)(ws + W_XB) + (size_t)hb * DM;
          pg8::Gemm g{XB1h, (const bf16_t*)(ws + W_BTG), NPR, DFF, 1024}; pg8::StaticOrder S; S.init(NPR, DFF, G, b);
          EpiGate E{(const float*)(ws + W_R2) + hb, (bf16_t*)(od + O_GATE)}; pg8::gemm_phase<EpiGate, pg8::StaticOrder>(lds, g, S, E); }
        GRID_SYNC(7 + 2 * h);
        PH(10) { KP_OPAQUE(p); unsigned char* ws = p->ws; unsigned char* od = (unsigned char*)p->out; const bf16_t* XB1h = (const bf16_t*)(ws + W_XB) + (size_t)hb * DM;
          pg8::Gemm g{XB1h, (const bf16_t*)(ws + W_BTU), NPR, DFF, 1024}; pg8::StaticOrder S; S.init(NPR, DFF, G, b);
          EpiUp E{(const float*)(ws + W_R2) + hb, (const bf16_t*)(od + O_GATE), p->in[14], p->in[15], (bf16_t*)(ws + W_ACT), hb}; pg8::gemm_phase<EpiUp, pg8::StaticOrder>(lds, g, S, E); }
        GRID_SYNC(8 + 2 * h);
        PH(11) { KP_OPAQUE(p); unsigned char* ws = p->ws;
          pg8::Gemm g{(const bf16_t*)(ws + W_ACT), (const bf16_t*)(ws + W_BTD), NPR, 1024, DFF}; pg8::StaticOrder S; S.init(NPR, 1024, G, b);
          EpiSS E{(bf16_t*)(ws + W_XB) + (size_t)hb * DM, (float*)(ws + W_SS3) + (size_t)hb * 16}; pg8::gemm_phase<EpiSS, pg8::StaticOrder>(lds, g, S, E); }
        if (h == 1) GRID_SYNC(11);
    }
    if constexpr (DBG_STOP == 8) { dbg_probe(p, 8); return; }
    PH(12) { KP_OPAQUE(p); phase9(p); }
}

extern "C" void kernel_launch(void* const* d_in, const int* in_sizes, int n_in, void* d_out, int out_size, void* d_ws, size_t ws_size, hipStream_t stream) {
    static int grid_blocks = 0;
    if (grid_blocks == 0) {
        if (n_in != 18 || in_sizes[0] != NPR * DM || in_sizes[1] != NPR * DM || out_size != MT * DM || ws_size < W_END) {
            fprintf(stderr, "kernel_launch: unexpected shapes / workspace (n_in %d, ws %zu, need %zu); nothing launched\n", n_in, ws_size, (size_t)W_END); grid_blocks = -1; return; }
        int dev = 0, cus = 0, per_cu = 0;
        (void)hipGetDevice(&dev); (void)hipDeviceGetAttribute(&cus, hipDeviceAttributeMultiprocessorCount, dev);
        if (hipFuncSetAttribute((const void*)mega_fwd, hipFuncAttributeMaxDynamicSharedMemorySize, LDS_BYTES) != hipSuccess) { fprintf(stderr, "kernel_launch: hipFuncSetAttribute failed\n"); grid_blocks = -1; return; }
        if (hipOccupancyMaxActiveBlocksPerMultiprocessor(&per_cu, (const void*)mega_fwd, 512, LDS_BYTES) != hipSuccess || per_cu < 1) { fprintf(stderr, "kernel_launch: occupancy query failed (%d)\n", per_cu); grid_blocks = -1; return; }
        grid_blocks = cus * per_cu; if (grid_blocks > 256) grid_blocks = 256;
    }
    if (grid_blocks < 0) return;
    Params p{};
    for (int i = 0; i < 18; ++i) p.in[i] = (const float*)d_in[i];
    p.out = (float*)d_out; p.ws = (unsigned char*)d_ws;
    if (hipMemsetAsync((char*)d_ws + W_BAR, 0, 256, stream) != hipSuccess) { fprintf(stderr, "kernel_launch: memset failed\n"); return; }
    void* args[] = {&p};
    hipError_t e = hipLaunchCooperativeKernel((const void*)mega_fwd, dim3(grid_blocks), dim3(512), args, LDS_BYTES, stream);
    if (e != hipSuccess) fprintf(stderr, "kernel_launch: cooperative launch failed: %s (grid %d)\n", hipGetErrorString(e), grid_blocks);
}
```

```cpp
#include <hip/hip_runtime.h>
#include <hip/hip_cooperative_groups.h>
#include <cstdio>
namespace cg = cooperative_groups;

namespace pg8 {
#define PG8_LAS __attribute__((address_space(3)))
typedef unsigned short bf16_t;
typedef short bf16x8 __attribute__((ext_vector_type(8)));
typedef float f32x4 __attribute__((ext_vector_type(4)));
typedef unsigned u32x4 __attribute__((ext_vector_type(4)));
constexpr int BM = 256, BK = 64, HALF = 128, HTB = HALF * BK * 2  , STAGE_BYTES = 8 * HTB, NXCD = 8, WGM = 8;

__host__ __device__ __forceinline__ int lds_byte(int r, int c) { const int st = (r >> 4) * 2 + (c >> 5), rr = r & 15, cc = c & 31, ob = rr * 64 + cc * 2; return st * 1024 + (ob ^ (((ob >> 9) & 1) << 5)); }
__host__ __device__ __forceinline__ void stage_rc(int b, int& R, int& C) { const int st = b / 1024, sb = b % 1024, swz = sb ^ (((sb >> 9) & 1) << 5); R = (st >> 1) * 16 + swz / 64; C = (st & 1) * 32 + (swz % 64) / 2; }
__host__ __device__ __forceinline__ int perm32(int rho) { const int n = rho >> 4, i = rho & 15; return 8 * (i >> 2) + 4 * n + (i & 3); }

struct Unit { int pm, pn; };
struct Gemm { const bf16_t* A; const bf16_t* Bt; int M, N, K; };

struct StaticOrder {
    int nM, nN, nwg, G, c;
    __host__ __device__ void init(int M, int N, int G_, int c_) { nM = M / BM; nN = N / BM; nwg = nM * nN; G = G_; c = c_; }
    __device__ __forceinline__ long long abase(const Unit& u, int K) const { return (long long)u.pm * (BM * 2) * K; }
    __host__ __device__ bool next(int i, Unit& u) const {
        const long L = (long)i * G + c; if (L >= nwg) return false;
        int wgid = (int)L; { const int q = nwg / NXCD, r = nwg % NXCD, xcd = wgid % NXCD, off = wgid / NXCD; wgid = (xcd < r ? xcd * (q + 1) : r * (q + 1) + (xcd - r) * q) + off; }
        const int nig = WGM * nN, gid = wgid / nig, fm = gid * WGM, gsz = (nM - fm) < WGM ? (nM - fm) : WGM;
        u.pm = fm + ((wgid % nig) % gsz); u.pn = (wgid % nig) / gsz; return true;
    }
    __device__ __forceinline__ void a_ready(const Unit&) const {}
    __device__ __forceinline__ void done(const Unit&) const {}
};

struct OverlapOrder : StaticOrder {
    int nT, slen;
    __host__ __device__ void init2(int slen_, int nseq, int N, int G_, int c_) { slen = slen_; nT = (slen_ + 253) / 254; nM = nseq * nT; nN = N / BM; nwg = nM * nN; G = G_; c = c_; }
    __device__ __forceinline__ int rowbase(int pm) const { const int sq = pm / nT, t = pm - sq * nT; return sq * slen + 254 * t - 1; }
    __device__ __forceinline__ long long abase(const Unit& u, int K) const { return (long long)rowbase(u.pm) * 2 * K; }
};

template <class Epi, class Sched, bool ALIGN_EPI = false, bool SP2 = false>
__device__ __forceinline__ void gemm_phase(PG8_LAS unsigned char* lds, const Gemm g, const Sched& S, const Epi& E) {
    int tid_ = threadIdx.x; asm volatile("" : "+v"(tid_));
    const int tid = tid_, wid = __builtin_amdgcn_readfirstlane(tid >> 6), lane = tid & 63, wr = wid >> 2, wc = wid & 3, fr = lane & 15, fq = lane >> 4;
    const int K = g.K, nt = K / BK;
    unsigned voffA[2], voffB[2];
#pragma unroll
    for (int i = 0; i < 2; ++i) { int R, C; stage_rc(tid * 16 + i * 8192, R, C); const int Rb = Epi::PERM ? ((R & ~31) + perm32(R & 31)) : R;
        voffA[i] = (unsigned)(R * K + C) * 2u; voffB[i] = (unsigned)(Rb * K + C) * 2u; }
    const size_t kstep = (size_t)(BK * 2);
    const size_t hstep = (size_t)HALF * K * 2;
    const size_t tstep = 2 * hstep;
    const unsigned ldsw = (unsigned)wid * 1024u;
    const int aoff = lds_byte(wr * 64 + fr, fq * 8), boff = lds_byte(wc * 32 + fr, fq * 8);
#define PG8_SA(b, h) (((b) * 2 + (h)) * HTB)
#define PG8_SB(b, h) ((4 + (b) * 2 + (h)) * HTB)
#define PG8_STAGE(bufoff, gbase, voff) do { _Pragma("unroll") for (int _i = 0; _i < 2; ++_i) \
        __builtin_amdgcn_global_load_lds((const unsigned*)((const char*)(gbase) + (voff)[_i]), (PG8_LAS unsigned*)(lds + (bufoff) + ldsw + _i * 8192), 16, 0, 0); } while (0)
#define PG8_LDA(dst, b, h) do { _Pragma("unroll") for (int m = 0; m < 4; ++m) _Pragma("unroll") for (int k = 0; k < 2; ++k) dst[m][k] = *(const PG8_LAS bf16x8*)(lds + PG8_SA(b, h) + aoff + m * 2048 + k * 1024); } while (0)
#define PG8_LDB(dst, b, h) do { _Pragma("unroll") for (int n = 0; n < 2; ++n) _Pragma("unroll") for (int k = 0; k < 2; ++k) dst[n][k] = *(const PG8_LAS bf16x8*)(lds + PG8_SB(b, h) + boff + n * 2048 + k * 1024); } while (0)
#define PG8_MMA(ai, bj, At, Bt) do { __builtin_amdgcn_s_setprio(1); _Pragma("unroll") for (int m = 0; m < 4; ++m) _Pragma("unroll") for (int n = 0; n < 2; ++n) _Pragma("unroll") for (int k = 0; k < 2; ++k) \
        acc[ai][bj][m][n] = __builtin_amdgcn_mfma_f32_16x16x32_bf16(Bt[n][k], At[m][k], acc[ai][bj][m][n], 0, 0, 0); __builtin_amdgcn_s_setprio(0); } while (0)
#define PG8_WAIT_V(n) asm volatile("s_waitcnt vmcnt(" #n ")" ::: "memory")
#define PG8_WAIT_L(n) asm volatile("s_waitcnt lgkmcnt(" #n ")" ::: "memory")
#define PG8_BAR __builtin_amdgcn_s_barrier()
#define PG8_SCHED __builtin_amdgcn_sched_barrier(0)
    Unit cur, nxt; int ui = 0;
    if (!S.next(0, cur)) return;
    f32x4 acc[2][2][4][2];
#pragma unroll
    for (int a = 0; a < 2; ++a)
#pragma unroll
        for (int b = 0; b < 2; ++b)
#pragma unroll
            for (int m = 0; m < 4; ++m)
#pragma unroll
                for (int n = 0; n < 2; ++n) acc[a][b][m][n] = (f32x4){0.f, 0.f, 0.f, 0.f};
    bf16x8 At[4][2], B0[2][2], B1[2][2];
    const char* cA = (const char*)g.A + S.abase(cur, K); const char* cB = (const char*)g.Bt + (size_t)cur.pn * tstep;
    S.a_ready(cur);
    if constexpr (SP2) {
        PG8_STAGE(PG8_SB(0, 0), cB, voffB); PG8_STAGE(PG8_SB(0, 1), cB + hstep, voffB); PG8_STAGE(PG8_SA(0, 0), cA, voffA); PG8_STAGE(PG8_SA(0, 1), cA + hstep, voffA);
        if (wr == 1) PG8_BAR;
        PG8_WAIT_V(2); PG8_BAR;
        PG8_STAGE(PG8_SB(1, 0), cB + kstep, voffB); PG8_STAGE(PG8_SA(1, 0), cA + kstep, voffA); PG8_STAGE(PG8_SB(1, 1), cB + hstep + kstep, voffB);
        PG8_WAIT_V(6); PG8_BAR;
    } else {
        PG8_STAGE(PG8_SB(0, 0), cB, voffB); PG8_STAGE(PG8_SA(0, 0), cA, voffA); PG8_STAGE(PG8_SB(0, 1), cB + hstep, voffB); PG8_STAGE(PG8_SA(0, 1), cA + hstep, voffA);
        if (wr == 1) PG8_BAR;
        PG8_WAIT_V(4); PG8_BAR;
        PG8_STAGE(PG8_SB(1, 0), cB + kstep, voffB); PG8_STAGE(PG8_SA(1, 0), cA + kstep, voffA); PG8_STAGE(PG8_SB(1, 1), cB + hstep + kstep, voffB);
        PG8_WAIT_V(6); PG8_BAR;
    }
    for (;;) {
        const bool has_next = S.next(ui + 1, nxt);
        const char* nA = has_next ? (const char*)g.A + S.abase(nxt, K) : cA; const char* nB = has_next ? (const char*)g.Bt + (size_t)nxt.pn * tstep : cB;
        for (int t = 0; t < nt; t += 2) {
            const bool last = (t == nt - 2);
            const char* a1 = cA + (size_t)(t + 1) * kstep;
            const char* a2 = last ? nA : cA + (size_t)(t + 2) * kstep; const char* b2 = last ? nB : cB + (size_t)(t + 2) * kstep;
            const char* a3 = a2 + kstep; const char* b3 = b2 + kstep;
            if (last && has_next) S.a_ready(nxt);
            if constexpr (SP2) {
            PG8_LDB(B0, 0, 0); PG8_LDB(B1, 0, 1); PG8_SCHED; PG8_LDA(At, 0, 0); PG8_STAGE(PG8_SA(1, 1), a1 + hstep, voffA);
            PG8_WAIT_V(8); PG8_WAIT_L(0); PG8_BAR; PG8_MMA(0, 0, At, B0); PG8_MMA(0, 1, At, B1); PG8_BAR; PG8_SCHED;
            PG8_LDA(At, 0, 1); PG8_STAGE(PG8_SB(0, 0), b2, voffB); PG8_STAGE(PG8_SB(0, 1), b2 + hstep, voffB); PG8_STAGE(PG8_SA(0, 0), a2, voffA);
            PG8_WAIT_V(8); PG8_WAIT_L(0); PG8_BAR; PG8_MMA(1, 0, At, B0); PG8_MMA(1, 1, At, B1); PG8_BAR; PG8_SCHED;
            PG8_LDB(B0, 1, 0); PG8_LDB(B1, 1, 1); PG8_SCHED; PG8_LDA(At, 1, 0); PG8_STAGE(PG8_SA(0, 1), a2 + hstep, voffA);
            PG8_WAIT_V(8); PG8_WAIT_L(0); PG8_BAR; PG8_MMA(0, 0, At, B0); PG8_MMA(0, 1, At, B1); PG8_BAR; PG8_SCHED;
            PG8_LDA(At, 1, 1); PG8_STAGE(PG8_SB(1, 0), b3, voffB); PG8_STAGE(PG8_SB(1, 1), b3 + hstep, voffB); PG8_STAGE(PG8_SA(1, 0), a3, voffA);
            PG8_WAIT_V(8); PG8_WAIT_L(0); PG8_BAR; PG8_MMA(1, 0, At, B0); PG8_MMA(1, 1, At, B1); PG8_BAR; PG8_SCHED;
            } else {
            PG8_LDB(B0, 0, 0); PG8_SCHED; PG8_LDA(At, 0, 0); PG8_STAGE(PG8_SA(1, 1), a1 + hstep, voffA);
            PG8_WAIT_L(8); PG8_BAR; PG8_WAIT_L(0); PG8_MMA(0, 0, At, B0); PG8_BAR; PG8_SCHED;
            PG8_LDB(B1, 0, 1); PG8_STAGE(PG8_SB(0, 0), b2, voffB);
            PG8_BAR; PG8_WAIT_L(0); PG8_MMA(0, 1, At, B1); PG8_BAR;
            PG8_LDA(At, 0, 1); PG8_STAGE(PG8_SA(0, 0), a2, voffA);
            PG8_BAR; PG8_WAIT_L(0); PG8_MMA(1, 0, At, B0); PG8_BAR; PG8_SCHED;
            PG8_STAGE(PG8_SB(0, 1), b2 + hstep, voffB);
            PG8_WAIT_V(6); PG8_BAR; PG8_MMA(1, 1, At, B1); PG8_BAR;
            PG8_LDB(B0, 1, 0); PG8_SCHED; PG8_LDA(At, 1, 0); PG8_STAGE(PG8_SA(0, 1), a2 + hstep, voffA);
            PG8_WAIT_L(8); PG8_BAR; PG8_WAIT_L(0); PG8_MMA(0, 0, At, B0); PG8_BAR; PG8_SCHED;
            PG8_LDB(B1, 1, 1); PG8_STAGE(PG8_SB(1, 0), b3, voffB);
            PG8_BAR; PG8_WAIT_L(0); PG8_MMA(0, 1, At, B1); PG8_BAR;
            PG8_LDA(At, 1, 1); PG8_STAGE(PG8_SA(1, 0), a3, voffA);
            PG8_BAR; PG8_WAIT_L(0); PG8_MMA(1, 0, At, B0); PG8_BAR; PG8_SCHED;
            PG8_STAGE(PG8_SB(1, 1), b3 + hstep, voffB);
            PG8_WAIT_V(6); PG8_BAR; PG8_MMA(1, 1, At, B1); PG8_BAR;
            }
        }
        if constexpr (ALIGN_EPI) { if (wr == 0) PG8_BAR; }
        if constexpr (!Epi::AFTER_DRAIN) { E(acc, cur, wr, wc, fr, fq); S.done(cur); }
        if (!has_next) break;
#pragma unroll
        for (int a = 0; a < 2; ++a)
#pragma unroll
            for (int b = 0; b < 2; ++b)
#pragma unroll
                for (int m = 0; m < 4; ++m)
#pragma unroll
                    for (int n = 0; n < 2; ++n) acc[a][b][m][n] = (f32x4){0.f, 0.f, 0.f, 0.f};
        cur = nxt; cA = nA; cB = nB; ++ui;
        if constexpr (ALIGN_EPI) { if (wr == 1) PG8_BAR; }
    }
    PG8_WAIT_V(0);
    if constexpr (!ALIGN_EPI) { if (wr == 0) PG8_BAR; }
    PG8_BAR;
    if constexpr (Epi::AFTER_DRAIN) { E.fused(acc, cur, wr, wc, fr, fq, lds, wid, lane); S.done(cur); }
#undef PG8_SA
#undef PG8_SB
#undef PG8_STAGE
#undef PG8_LDA
#undef PG8_LDB
#undef PG8_MMA
#undef PG8_WAIT_V
#undef PG8_WAIT_L
#undef PG8_BAR
#undef PG8_SCHED
}

}

using pg8::bf16_t; using pg8::bf16x8; using pg8::f32x4; using pg8::u32x4; using pg8::Unit;
typedef float f32x16 __attribute__((ext_vector_type(16)));
typedef short s16x4 __attribute__((ext_vector_type(4)));
typedef unsigned u32x2 __attribute__((ext_vector_type(2)));

constexpr int MT = 32768, NPR = 16384, DM = 1024, DFF = 2816, NIN = 1056;
constexpr float EPS = 1e-6f;
constexpr float QSCALE = 0.10206207261596575f * 1.4426950408889634f;
constexpr size_t MiB = 1048576;
constexpr size_t W_BT1 = 0, W_BT2Q = W_BT1 + 1792 * 1024 * 2, W_BT2KV = W_BT2Q + 768 * 256 * 2, W_BTOUT = W_BT2KV + 1024 * 256 * 2, W_BTG = W_BTOUT + 1024 * 1024 * 2,
                 W_BTU = W_BTG + (size_t)DFF * 1024 * 2, W_BTD = W_BTU + (size_t)DFF * 1024 * 2, W_F1 = W_BTD + (size_t)DFF * 1024 * 2, W_F2A = W_F1 + 128 * 128 * 2, W_F2B = W_F2A + 128 * 256 * 2,
                 W_RCOS = W_F2B + 64 * 128 * 2, W_RSIN = W_RCOS + 8192 * 16 * 4, W_TW = W_RSIN + 8192 * 16 * 4, W_RX = W_TW + 8192 * 8, W_R2 = W_RX + MT * 4, W_SSP = W_R2 + MT * 4,
                 W_SS2 = W_SSP + (size_t)MT * 8 * 4, W_SS3 = W_SS2 + (size_t)MT * 16 * 4, W_KRP = W_SS3 + (size_t)MT * 16 * 4, W_BAR = W_KRP + (size_t)MT * 32 * 2, W_TS = W_BAR + 16384, W_SMALL_END = W_TS + 256;
static_assert(W_SMALL_END <= 32 * MiB, "small region");
constexpr size_t W_XB = 32 * MiB  , W_MIX = 96 * MiB  , W_CQ = W_MIX, W_CKV = W_MIX + 16 * MiB, W_ACT = 160 * MiB  , W_VC = W_ACT, W_AF = W_ACT,
                 W_END = 248 * MiB;
constexpr size_t O_Q = 0, O_KN = 48 * MiB, O_VV = 80 * MiB, O_ACT1 = 0;
#ifndef GEMM_ALIGN
#define GEMM_ALIGN true
#endif
#ifndef GEMM_SP2
#define GEMM_SP2 true
#endif
constexpr int LDS_X = 131072 + 64, LDS_BYTES = LDS_X + 2048;

#ifndef DIAG_A
#define DIAG_A -1
#define DIAG_B 0
#define DIAG_C 0
#define DIAG_D 0
#endif
struct Params { const float* in[18]; float* out; unsigned char* ws; };
typedef const __attribute__((address_space(4))) Params* KP;
#define KP_OPAQUE(p) asm volatile("" : "+s"(p))

typedef __bf16 bf16x2_t __attribute__((ext_vector_type(2)));
typedef float f32x2_t __attribute__((ext_vector_type(2)));
__device__ __forceinline__ unsigned cvtpk(float lo, float hi) { f32x2_t v = {lo, hi}; bf16x2_t b = __builtin_convertvector(v, bf16x2_t); return __builtin_bit_cast(unsigned, b); }
__device__ __forceinline__ bf16_t f2bf(float f) { return (bf16_t)(cvtpk(f, 0.f) & 0xffffu); }
__device__ __forceinline__ u32x4 pack8(f32x4 a, f32x4 b) { u32x4 w; w.x = cvtpk(a[0], a[1]); w.y = cvtpk(a[2], a[3]); w.z = cvtpk(b[0], b[1]); w.w = cvtpk(b[2], b[3]); return w; }
__device__ __forceinline__ float bflo(unsigned u) { return __uint_as_float(u << 16); }
__device__ __forceinline__ float bfhi(unsigned u) { return __uint_as_float(u & 0xffff0000u); }
__device__ __forceinline__ void unpack8(u32x4 w, f32x4& a, f32x4& b) { a = (f32x4){bflo(w.x), bfhi(w.x), bflo(w.y), bfhi(w.y)}; b = (f32x4){bflo(w.z), bfhi(w.z), bflo(w.w), bfhi(w.w)}; }
__device__ __forceinline__ int tok_pos(int row) { return row < NPR ? (row & 8191) : (row & 4095); }
__device__ __forceinline__ int tok_len(int row) { return row < NPR ? 8192 : 4096; }
__device__ __forceinline__ float wave_sum(float v) { for (int o = 32; o >= 1; o >>= 1) v += __shfl_xor(v, o); return v; }

#define EPI_ARGS const f32x4 (&acc)[2][2][4][2], const Unit& u, int wr, int wc, int fr_, int fq_
#define EPI_LOCALS int t_ = threadIdx.x; asm volatile("" : "+v"(t_)); const int fr = t_ & 15, fq = (t_ >> 4) & 3;
struct Epi1 {
    static constexpr bool PERM = true, AFTER_DRAIN = false;
    const float* RX; bf16_t* CQ; bf16_t* CKV; float* SSP; bf16_t* VC; bf16_t* KRP; const float* RCOS; const float* RSIN;
    __device__ __forceinline__ void operator()(EPI_ARGS) const {
        EPI_LOCALS
        const int row0 = u.pm * 256 + wr * 64 + fr, colt = wc * 32 + 8 * fq; float rxv[2][4];
#pragma unroll
        for (int ai = 0; ai < 2; ++ai)
#pragma unroll
            for (int m = 0; m < 4; ++m) rxv[ai][m] = RX[row0 + ai * 128 + m * 16];
        if (u.pn < 2) {
            bf16_t* dst = u.pn == 0 ? CQ : CKV;
#pragma unroll
            for (int ai = 0; ai < 2; ++ai)
#pragma unroll
                for (int m = 0; m < 4; ++m) { const int row = row0 + ai * 128 + m * 16; const float rx = rxv[ai][m]; float ss = 0.f;
#pragma unroll
                    for (int bj = 0; bj < 2; ++bj) { const f32x4 v0 = acc[ai][bj][m][0] * rx, v1 = acc[ai][bj][m][1] * rx;
                        ss += (v0[0] * v0[0] + v0[1] * v0[1]) + (v0[2] * v0[2] + v0[3] * v0[3]) + (v1[0] * v1[0] + v1[1] * v1[1]) + (v1[2] * v1[2] + v1[3] * v1[3]);
                        *(u32x4*)(dst + (unsigned)(row * 256 + bj * 128 + colt)) = pack8(v0, v1); }
                    ss += __shfl_xor(ss, 16); ss += __shfl_xor(ss, 32);
                    if (fq == 0) SSP[(unsigned)(row * 8 + u.pn * 4 + wc)] = ss; }
        } else if (u.pn < 6) {
#pragma unroll
            for (int ai = 0; ai < 2; ++ai)
#pragma unroll
                for (int m = 0; m < 4; ++m) { const int row = row0 + ai * 128 + m * 16; const float rx = rxv[ai][m];
#pragma unroll
                    for (int bj = 0; bj < 2; ++bj) *(u32x4*)(VC + (unsigned)(row * 1024 + (u.pn - 2) * 256 + bj * 128 + colt)) = pack8(acc[ai][bj][m][0] * rx, acc[ai][bj][m][1] * rx); }
        } else if (wc == 0) {
#pragma unroll
            for (int ai = 0; ai < 2; ++ai)
#pragma unroll
                for (int m = 0; m < 4; ++m) { const int row = row0 + ai * 128 + m * 16; const float rx = rxv[ai][m]; const int pos = tok_pos(row);
                    const f32x4 c4 = *(const f32x4*)(RCOS + pos * 16 + 4 * fq), s4 = *(const f32x4*)(RSIN + pos * 16 + 4 * fq);
                    const f32x4 x1 = acc[ai][0][m][0] * rx, x2 = acc[ai][0][m][1] * rx;
                    *(u32x4*)(KRP + (unsigned)(row * 32 + 8 * fq)) = pack8(x1 * c4 - x2 * s4, x2 * c4 + x1 * s4); }
        }
    }
};
struct Epi2Q {
    static constexpr bool PERM = true, AFTER_DRAIN = false;
    const float* SSP; bf16_t* Q;
    __device__ __forceinline__ void operator()(EPI_ARGS) const {
        EPI_LOCALS
        const int row0 = u.pm * 256 + wr * 64 + fr;
        const int G0 = 32 * u.pn + 4 * wc + fq, h0 = G0 / 12, p0 = G0 - 12 * h0, G1 = G0 + 16, h1 = G1 / 12, p1 = G1 - 12 * h1;
        const unsigned base0 = (unsigned)(h0 * MT * 96 + 8 * p0), base1 = (unsigned)(h1 * MT * 96 + 8 * p1);
#pragma unroll
        for (int ai = 0; ai < 2; ++ai) { float rq[4];
#pragma unroll
            for (int m = 0; m < 4; ++m) { const f32x4 sp = *(const f32x4*)(SSP + (unsigned)((row0 + ai * 128 + m * 16) * 8)); rq[m] = rsqrtf(((sp[0] + sp[1]) + (sp[2] + sp[3])) * (1.0f / 256.0f) + EPS); }
#pragma unroll
            for (int m = 0; m < 4; ++m) { const unsigned ro = (unsigned)((row0 + ai * 128 + m * 16) * 96);
                *(u32x4*)(Q + base0 + ro) = pack8(acc[ai][0][m][0] * rq[m], acc[ai][0][m][1] * rq[m]);
                *(u32x4*)(Q + base1 + ro) = pack8(acc[ai][1][m][0] * rq[m], acc[ai][1][m][1] * rq[m]); }
            asm volatile("" ::: "memory"); }
    }
};
struct Epi2KV {
    static constexpr bool PERM = true, AFTER_DRAIN = false;
    const float* SSP; bf16_t* KN; bf16_t* VV;
    __device__ __forceinline__ void operator()(EPI_ARGS) const {
        EPI_LOCALS
        const int row0 = u.pm * 256 + wr * 64 + fr; const int within = (wc & 1) * 32 + 8 * fq; bf16_t* dst = wc < 2 ? KN : VV; float rk[2][4];
#pragma unroll
        for (int ai = 0; ai < 2; ++ai)
#pragma unroll
            for (int m = 0; m < 4; ++m) { const f32x4 sp = *(const f32x4*)(SSP + (unsigned)((row0 + ai * 128 + m * 16) * 8 + 4)); rk[ai][m] = rsqrtf(((sp[0] + sp[1]) + (sp[2] + sp[3])) * (1.0f / 256.0f) + EPS); }
#pragma unroll
        for (int ai = 0; ai < 2; ++ai)
#pragma unroll
            for (int m = 0; m < 4; ++m) { const int row = row0 + ai * 128 + m * 16;
#pragma unroll
                for (int bj = 0; bj < 2; ++bj) { const int head = 2 * u.pn + bj;
                    *(u32x4*)(dst + (unsigned)((head * MT + row) * 64 + within)) = pack8(acc[ai][bj][m][0] * rk[ai][m], acc[ai][bj][m][1] * rk[ai][m]); } }
    }
};
struct EpiSS {
    static constexpr bool PERM = true, AFTER_DRAIN = false;
    bf16_t* O; float* SS;
    __device__ __forceinline__ void operator()(EPI_ARGS) const {
        EPI_LOCALS
        const int row0 = u.pm * 256 + wr * 64 + fr, colt = u.pn * 256 + wc * 32 + 8 * fq;
#pragma unroll
        for (int ai = 0; ai < 2; ++ai)
#pragma unroll
            for (int m = 0; m < 4; ++m) { const int row = row0 + ai * 128 + m * 16; float ss = 0.f;
#pragma unroll
                for (int bj = 0; bj < 2; ++bj) { const f32x4 v0 = acc[ai][bj][m][0], v1 = acc[ai][bj][m][1];
                    ss += (v0[0] * v0[0] + v0[1] * v0[1]) + (v0[2] * v0[2] + v0[3] * v0[3]) + (v1[0] * v1[0] + v1[1] * v1[1]) + (v1[2] * v1[2] + v1[3] * v1[3]);
                    *(u32x4*)(O + (unsigned)(row * 1024 + bj * 128 + colt)) = pack8(v0, v1); }
                ss += __shfl_xor(ss, 16); ss += __shfl_xor(ss, 32);
                if (fq == 0) SS[(unsigned)(row * 16 + u.pn * 4 + wc)] = ss; }
    }
};
struct EpiGate {
    static constexpr bool PERM = true, AFTER_DRAIN = false;
    const float* R2; bf16_t* G;
    __device__ __forceinline__ void operator()(EPI_ARGS) const {
        EPI_LOCALS
        const int row0 = u.pm * 256 + wr * 64 + fr, colt = u.pn * 256 + wc * 32 + 8 * fq;
#pragma unroll
        for (int ai = 0; ai < 2; ++ai)
#pragma unroll
            for (int m = 0; m < 4; ++m) { const int row = row0 + ai * 128 + m * 16; const float r2 = R2[row];
#pragma unroll
                for (int bj = 0; bj < 2; ++bj) *(u32x4*)(G + (unsigned)(row * DFF + bj * 128 + colt)) = pack8(acc[ai][bj][m][0] * r2, acc[ai][bj][m][1] * r2); }
    }
};
__device__ __forceinline__ float gelu_t(float x) {
    const float u2 = x * (1.5957691216057308f + 0.07135481627159855f * x * x);
    return x * __builtin_amdgcn_rcpf(1.0f + __builtin_amdgcn_exp2f(-1.4426950408889634f * u2));
}
__device__ __forceinline__ f32x4 gelu_mul4(f32x4 x, f32x4 y) {
    const f32x4 t = x * (x * x * (-0.10294324283f) + (-2.3022081910f));
    f32x4 e; e[0] = __builtin_amdgcn_exp2f(t[0]); e[1] = __builtin_amdgcn_exp2f(t[1]); e[2] = __builtin_amdgcn_exp2f(t[2]); e[3] = __builtin_amdgcn_exp2f(t[3]);
    const f32x4 d = e + 1.0f; f32x4 r; r[0] = __builtin_amdgcn_rcpf(d[0]); r[1] = __builtin_amdgcn_rcpf(d[1]); r[2] = __builtin_amdgcn_rcpf(d[2]); r[3] = __builtin_amdgcn_rcpf(d[3]);
    return (x * y) * r;
}
template <int CTRL> __device__ __forceinline__ u32x4 dppv(u32x4 old, u32x4 src) {
    u32x4 r; r.x = (unsigned)__builtin_amdgcn_update_dpp((int)old.x, (int)src.x, CTRL, 0xf, 0xf, false); r.y = (unsigned)__builtin_amdgcn_update_dpp((int)old.y, (int)src.y, CTRL, 0xf, 0xf, false);
    r.z = (unsigned)__builtin_amdgcn_update_dpp((int)old.z, (int)src.z, CTRL, 0xf, 0xf, false); r.w = (unsigned)__builtin_amdgcn_update_dpp((int)old.w, (int)src.w, CTRL, 0xf, 0xf, false); return r; }
struct EpiUp {
    static constexpr bool PERM = true, AFTER_DRAIN = false;
    const float* R2; const bf16_t* G; const float* CW; const float* CB; bf16_t* ACT; int hb;
    __device__ __forceinline__ void operator()(EPI_ARGS) const {
        EPI_LOCALS
        const int row0 = u.pm * 256 + wr * 64 + fr;
#pragma unroll
        for (int bj = 0; bj < 2; ++bj) { const int col = u.pn * 256 + bj * 128 + wc * 32 + 8 * fq;
            const f32x4 w0a = *(const f32x4*)(CW + col), w0b = *(const f32x4*)(CW + col + 4), w1a = *(const f32x4*)(CW + DFF + col), w1b = *(const f32x4*)(CW + DFF + col + 4),
                        w2a = *(const f32x4*)(CW + 2 * DFF + col), w2b = *(const f32x4*)(CW + 2 * DFF + col + 4), ba = *(const f32x4*)(CB + col), bb = *(const f32x4*)(CB + col + 4);
#pragma unroll
            for (int ai = 0; ai < 2; ++ai) { const int rA = row0 + ai * 128, rZ = rA + 48; const bf16_t* gp = G + (unsigned)(rA * DFF + col);
                u32x4 cen[4], pb = {0u, 0u, 0u, 0u}, nb = {0u, 0u, 0u, 0u}; float r2v[4];
#pragma unroll
                for (int m = 0; m < 4; ++m) { cen[m] = *(const u32x4*)(gp + m * 16 * DFF); r2v[m] = R2[rA + m * 16]; }
                if (fr == 0 && tok_pos(hb + rA) > 0) pb = *(const u32x4*)(gp - DFF);
                if (fr == 15 && tok_pos(hb + rZ) < tok_len(hb + rZ) - 1) nb = *(const u32x4*)(gp + 49 * DFF);
#pragma unroll
                for (int m = 0; m < 4; ++m) { const int row = rA + m * 16;
                    const u32x4 tp = (m == 0) ? pb : dppv<0x121>(cen[m == 0 ? 0 : m - 1], cen[m == 0 ? 0 : m - 1]);
                    const u32x4 tn = (m == 3) ? nb : dppv<0x12F>(cen[m == 3 ? 3 : m + 1], cen[m == 3 ? 3 : m + 1]);
                    const u32x4 w0 = dppv<0x111>(tp, cen[m]), w2 = dppv<0x101>(tn, cen[m]);
                    f32x4 g0a, g0b, g1a, g1b, g2a, g2b; unpack8(w0, g0a, g0b); unpack8(cen[m], g1a, g1b); unpack8(w2, g2a, g2b);
                    const f32x4 ta = ba + w0a * g0a + w1a * g1a + w2a * g2a, tb = bb + w0b * g0b + w1b * g1b + w2b * g2b;
                    const f32x4 ua = acc[ai][bj][m][0] * r2v[m], ub = acc[ai][bj][m][1] * r2v[m];
                    f32x4 oa, ob;
#pragma unroll
                    for (int j = 0; j < 4; ++j) { oa[j] = gelu_t(ta[j]) * ua[j]; ob[j] = gelu_t(tb[j]) * ub[j]; }
                    *(u32x4*)(ACT + (unsigned)(row * DFF + col)) = pack8(oa, ob); }
                asm volatile("" ::: "memory"); } }
    }
};

struct EpiGU {
    static constexpr bool PERM = true, AFTER_DRAIN = false;
    const float* R2; const float* CW; const float* CB; bf16_t* ACT; PG8_LAS unsigned* X; int hb, slen, nT;
    __device__ __forceinline__ void operator()(EPI_ARGS) const {
        EPI_LOCALS
        const int sq = u.pm / nT, tt = u.pm - sq * nT, rb = sq * slen + 254 * tt - 1;
        const int col = u.pn * 128 + wc * 32 + 8 * fq, li0 = wr * 64 + fr;
        float r2v[2][4];
#pragma unroll
        for (int ai = 0; ai < 2; ++ai)
#pragma unroll
            for (int m = 0; m < 4; ++m) { int gr = hb + rb + ai * 128 + li0 + m * 16; gr = gr < 0 ? 0 : (gr > MT - 1 ? MT - 1 : gr); r2v[ai][m] = R2[gr]; }
        const f32x4 w0a = *(const f32x4*)(CW + col), w0b = *(const f32x4*)(CW + col + 4), w1a = *(const f32x4*)(CW + DFF + col), w1b = *(const f32x4*)(CW + DFF + col + 4),
                    w2a = *(const f32x4*)(CW + 2 * DFF + col), w2b = *(const f32x4*)(CW + 2 * DFF + col + 4), ba = *(const f32x4*)(CB + col), bb = *(const f32x4*)(CB + col + 4);
#pragma unroll
        for (int ai = 0; ai < 2; ++ai) { PG8_LAS unsigned* xs = X + (((wr * 4 + wc) * 2 + ai) * 2) * 16 + fq * 4;
            if (fr == 0) *(PG8_LAS u32x4*)xs = pack8(acc[ai][0][0][0] * r2v[ai][0], acc[ai][0][0][1] * r2v[ai][0]);
            if (fr == 15) *(PG8_LAS u32x4*)(xs + 16) = pack8(acc[ai][0][3][0] * r2v[ai][3], acc[ai][0][3][1] * r2v[ai][3]); }
        asm volatile("s_waitcnt lgkmcnt(0)" ::: "memory"); __builtin_amdgcn_s_barrier(); if (!GEMM_ALIGN && wr == 0) __builtin_amdgcn_s_barrier(); asm volatile("" ::: "memory");
        const int pw = wr ^ 1;
#pragma unroll
        for (int ai = 0; ai < 2; ++ai) {
            const int pai = wr ? ai : ai - 1, nai = wr ? ai + 1 : ai;
            u32x4 pb = {0u, 0u, 0u, 0u}, nb = {0u, 0u, 0u, 0u};
            if (pai >= 0) pb = *(const PG8_LAS u32x4*)(X + (((pw * 4 + wc) * 2 + pai) * 2 + 1) * 16 + fq * 4);
            if (nai <= 1) nb = *(const PG8_LAS u32x4*)(X + (((pw * 4 + wc) * 2 + nai) * 2 + 0) * 16 + fq * 4);
            u32x4 cen[4];
#pragma unroll
            for (int m = 0; m < 4; ++m) cen[m] = pack8(acc[ai][0][m][0] * r2v[ai][m], acc[ai][0][m][1] * r2v[ai][m]);
#pragma unroll
            for (int m = 0; m < 4; ++m) { const int li = ai * 128 + li0 + m * 16, row = rb + li, pos = row - sq * slen;
                const u32x4 tp = (m == 0) ? pb : dppv<0x121>(cen[m == 0 ? 0 : m - 1], cen[m == 0 ? 0 : m - 1]);
                const u32x4 tn = (m == 3) ? nb : dppv<0x12F>(cen[m == 3 ? 3 : m + 1], cen[m == 3 ? 3 : m + 1]);
                u32x4 w0 = dppv<0x111>(tp, cen[m]), w2 = dppv<0x101>(tn, cen[m]);
                if (pos == 0) w0 = (u32x4){0u, 0u, 0u, 0u};
                if (pos == slen - 1) w2 = (u32x4){0u, 0u, 0u, 0u};
                f32x4 g0a, g0b, g1a, g1b, g2a, g2b; unpack8(w0, g0a, g0b); unpack8(cen[m], g1a, g1b); unpack8(w2, g2a, g2b);
                const f32x4 ta = ba + w0a * g0a + w1a * g1a + w2a * g2a, tb = bb + w0b * g0b + w1b * g1b + w2b * g2b;
                const f32x4 ua = acc[ai][1][m][0] * r2v[ai][m], ub = acc[ai][1][m][1] * r2v[ai][m];
                const f32x4 oa = gelu_mul4(ta, ua), ob = gelu_mul4(tb, ub);
                if (li >= 1 && li <= 254 && pos >= 0 && pos < slen) *(u32x4*)(ACT + (unsigned)(row * DFF + col)) = pack8(oa, ob); }
            asm volatile("" ::: "memory"); }
        if (!GEMM_ALIGN && wr == 1) { asm volatile("s_waitcnt lgkmcnt(0)" ::: "memory"); __builtin_amdgcn_s_barrier(); }
    }
};

template <class F> __device__ __forceinline__ void ttile(const F& src, bf16_t* dst, int lddst, int k0, int n0, float* tile) {
    const int tid = threadIdx.x, a = tid >> 6, b = tid & 63;
#pragma unroll
    for (int i = 0; i < 8; ++i) { const int kk = a + 8 * i; tile[kk * 65 + b] = src(k0 + kk, n0 + b); }
    __syncthreads();
    const int a2 = tid >> 5, b2 = (tid & 31) * 2;
#pragma unroll
    for (int i = 0; i < 4; ++i) { const int nn = a2 + 16 * i; *(unsigned*)(dst + (size_t)(n0 + nn) * lddst + k0 + b2) = cvtpk(tile[b2 * 65 + nn], tile[(b2 + 1) * 65 + nn]); }
    __syncthreads();
}
__device__ __forceinline__ void ttile128(const float* w, int ld, const float* g, bf16_t* dst, int lddst, int k0, int n0, int dstrow0, float* tile, int tid) {
#pragma unroll
    for (int i = 0; i < 8; ++i) { const int idx = tid + 512 * i, kk = idx >> 5, n4 = (idx & 31) * 4;
        f32x4 v = *(const f32x4*)(w + (size_t)(k0 + kk) * ld + n0 + n4); if (g) v = v * g[k0 + kk];
        float* t = tile + kk * 129 + n4; t[0] = v[0]; t[1] = v[1]; t[2] = v[2]; t[3] = v[3]; }
    __syncthreads();
#pragma unroll
    for (int i = 0; i < 4; ++i) { const int idx = tid + 512 * i, nn = idx >> 4, k8 = (idx & 15) * 8; const float* t = tile + k8 * 129 + nn;
        u32x4 o; o.x = cvtpk(t[0], t[129]); o.y = cvtpk(t[2 * 129], t[3 * 129]); o.z = cvtpk(t[4 * 129], t[5 * 129]); o.w = cvtpk(t[6 * 129], t[7 * 129]);
        *(u32x4*)(dst + (size_t)(dstrow0 + nn) * lddst + k0 + k8) = o; }
    __syncthreads();
}
struct SrcPlain { const float* w; int ld; const float* g; float mul; __device__ __forceinline__ float operator()(int k, int n) const { return w[(size_t)k * ld + n] * (g ? g[k] : 1.0f) * mul; } };
struct SrcQ { const float* w; const float* g; __device__ __forceinline__ float operator()(int k, int n) const {
    const int G = n >> 3, i8 = n & 7, head = G / 12, part = G - 12 * head; int oc;
    if (part < 8) oc = head * 96 + 8 * part + i8; else { const int i = part - 8; oc = head * 96 + 64 + (i8 < 4 ? 4 * i + i8 : 16 + 4 * i + (i8 - 4)); }
    return w[(size_t)k * 768 + oc] * g[k] * QSCALE; } };
struct SrcKR { const float* w; const float* g; __device__ __forceinline__ float operator()(int k, int p) const {
    if (p >= 32) return 0.f; const int oc = 512 + ((p >> 2) & 1) * 16 + 4 * (p >> 3) + (p & 3); return w[(size_t)k * NIN + oc] * g[k]; } };
struct SrcV { const float* w; const float* g; const float* cs; __device__ __forceinline__ float operator()(int k, int n) const {
    const int chp = n >> 1, reim = n & 1, grp = chp >> 7, cp = chp & 127; const float* wr = w + (size_t)k * NIN + 544 + grp * 128; float s = 0.f;
    for (int c = 0; c < 128; ++c) s += wr[c] * cs[2 * ((c * cp) & 127) + reim];
    return s * g[k] * 0.08838834764831845f; } };
struct SrcFO { const float* wf; const float* wo; __device__ __forceinline__ float operator()(int k, int n) const {
    const int kk = k - 512, grp = kk >> 7; const float* a = wf + (size_t)kk * 128; const float* b = wo + (size_t)(512 + grp * 128) * 1024 + n; float s = 0.f;
    for (int c2 = 0; c2 < 128; ++c2) s += a[c2] * b[(size_t)c2 * 1024];
    return s; } };

template <class FA, class FB> __device__ __forceinline__ void tile_mm(const FA& fa, const FB& fb, bf16_t* dst, int lddst, int k0, int n0, float* tile, float* As, float* Bs) {
    const int tid = threadIdx.x, a = tid >> 6, b = tid & 63;
#pragma unroll
    for (int i = 0; i < 16; ++i) { const int idx = tid + 512 * i; As[(idx >> 7) * 132 + (idx & 127)] = fa(idx >> 7, idx & 127); }
#pragma unroll
    for (int i = 0; i < 16; ++i) { const int idx = tid + 512 * i; Bs[idx] = fb(idx >> 6, idx & 63); }
    __syncthreads();
    float acc[8] = {0.f, 0.f, 0.f, 0.f, 0.f, 0.f, 0.f, 0.f};
    for (int c = 0; c < 128; c += 4) { const float b0 = Bs[c * 64 + b], b1 = Bs[(c + 1) * 64 + b], b2 = Bs[(c + 2) * 64 + b], b3 = Bs[(c + 3) * 64 + b];
#pragma unroll
        for (int i = 0; i < 8; ++i) { const f32x4 av = *(const f32x4*)(As + (a + 8 * i) * 132 + c); acc[i] += (av[0] * b0 + av[1] * b1) + (av[2] * b2 + av[3] * b3); } }
#pragma unroll
    for (int i = 0; i < 8; ++i) tile[(a + 8 * i) * 65 + b] = acc[i];
    __syncthreads();
    const int a2 = tid >> 5, b2_ = (tid & 31) * 2;
#pragma unroll
    for (int i = 0; i < 4; ++i) { const int nn = a2 + 16 * i; *(unsigned*)(dst + (size_t)(n0 + nn) * lddst + k0 + b2_) = cvtpk(tile[b2_ * 65 + nn], tile[(b2_ + 1) * 65 + nn]); }
    __syncthreads();
}
struct MmVA { const float* w; const float* g; int k0, grp; __device__ __forceinline__ float operator()(int kk, int c) const { return w[(size_t)(k0 + kk) * NIN + 544 + grp * 128 + c] * g[k0 + kk] * 0.08838834764831845f; } };
struct MmVB { const float* cs; int n0; __device__ __forceinline__ float operator()(int c, int nn) const { const int n = n0 + nn, cp = (n >> 1) & 127; return cs[2 * ((c * cp) & 127) + (n & 1)]; } };
struct MmFA { const float* wf; int kb; __device__ __forceinline__ float operator()(int kk, int c2) const { return wf[(size_t)(kb + kk) * 128 + c2]; } };
struct MmFB { const float* wo; int grp, n0; __device__ __forceinline__ float operator()(int c2, int nn) const { return wo[(size_t)(512 + grp * 128 + c2) * 1024 + n0 + nn]; } };

__device__ __forceinline__ void phase0(KP p, unsigned char* shm) {
    int tid_ = threadIdx.x; asm volatile("" : "+v"(tid_));
    const int tid = tid_, lane = tid & 63, wid = tid >> 6, G = gridDim.x, b = blockIdx.x;
    unsigned char* ws = p->ws;
    float* tile = (float*)shm; float* cs = (float*)(shm + 102400); float* As = (float*)(shm + 32768); float* Bs = (float*)(shm + 32768 + 64 * 132 * 4);
    if (tid < 128) { float s, c; sincospif((float)tid * (1.0f / 64.0f), &s, &c); cs[2 * tid] = c; cs[2 * tid + 1] = -s; }
    __syncthreads();
    const float *x_in = p->in[2]  , *w_in = p->in[3], *g_q = p->in[4], *w_uq = p->in[5], *g_kv = p->in[6], *w_ukv = p->in[7], *w_fnet = p->in[8], *w_out = p->in[9],
                *g_pre_ffn = p->in[11], *w_gate = p->in[12], *w_up = p->in[13], *w_down = p->in[16];
    bf16_t *BT1 = (bf16_t*)(ws + W_BT1), *BT2Q = (bf16_t*)(ws + W_BT2Q), *BT2KV = (bf16_t*)(ws + W_BT2KV), *BTOUT = (bf16_t*)(ws + W_BTOUT), *BTG = (bf16_t*)(ws + W_BTG), *BTU = (bf16_t*)(ws + W_BTU), *BTD = (bf16_t*)(ws + W_BTD);
    constexpr int J0 = 256, J1 = J0 + 128, J2 = J1 + 32, J3 = J2 + 16, J4 = J3 + 32, J5 = J4  , J6 = J5, J7 = J6, J8 = J7 + 48, J9 = J8 + 64;
    bf16_t* XB = (bf16_t*)(ws + W_XB); float* RX = (float*)(ws + W_RX);
    int rowA = b * 8 + wid; f32x4 rv[2][4]; int rrow[2] = {0, 0};
#define ROWS_LOAD() do { rrow[0] = rowA; rrow[1] = rowA + G * 8 < MT ? rowA + G * 8 : rowA; _Pragma("unroll") for (int q = 0; q < 2; ++q) { \
        const float* xr = rrow[q] < NPR ? p->in[0] + (size_t)rrow[q] * DM : p->in[1] + (size_t)(rrow[q] - NPR) * DM; _Pragma("unroll") for (int j = 0; j < 4; ++j) rv[q][j] = __builtin_nontemporal_load((const f32x4*)(xr + j * 256 + lane * 4)); } } while (0)
#define ROWS_FINISH() do { _Pragma("unroll") for (int q = 0; q < 2; ++q) { float ss = 0.f; \
        _Pragma("unroll") for (int j = 0; j < 4; ++j) ss += (rv[q][j][0] * rv[q][j][0] + rv[q][j][1] * rv[q][j][1]) + (rv[q][j][2] * rv[q][j][2] + rv[q][j][3] * rv[q][j][3]); \
        ss = wave_sum(ss); if (lane == 0) RX[rrow[q]] = rsqrtf(ss * (1.0f / 1024.0f) + EPS); \
        _Pragma("unroll") for (int j = 0; j < 4; ++j) { u32x2 w; w.x = cvtpk(rv[q][j][0], rv[q][j][1]); w.y = cvtpk(rv[q][j][2], rv[q][j][3]); *(u32x2*)(XB + (size_t)rrow[q] * DM + j * 256 + lane * 4) = w; } } rowA += 2 * G * 8; } while (0)
    for (int t = b; t < J9; t += G) {
        const bool hasrow = rowA < MT; if (hasrow) ROWS_LOAD();
        if (t < J0) { const int j = t, k0 = (j & 15) * 64, n0 = (j >> 4) * 64; tile_mm(MmVA{w_in, x_in, k0, n0 >> 8}, MmVB{cs, n0}, BT1 + (size_t)512 * 1024, 1024, k0, n0, tile, As, Bs); }
        else if (t < J1) { const int j = t - J0, kb = (j & 7) * 64, n0 = (j >> 3) * 64; tile_mm(MmFA{w_fnet, kb}, MmFB{w_out, kb >> 7, n0}, BTOUT, 1024, 512 + kb, n0, tile, As, Bs); }
        else if (t < J2) { const int j = t - J1; ttile128(w_in, NIN, x_in, BT1, 1024, (j & 7) * 128, (j >> 3) * 128, (j >> 3) * 128, tile, tid); }
        else if (t < J3) { const int j = t - J2; ttile128(w_ukv, 1024, g_kv, BT2KV, 256, (j & 1) * 128, (j >> 1) * 128, (j >> 1) * 128, tile, tid); }
        else if (t < J4) { const int j = t - J3; ttile128(w_out, 1024, nullptr, BTOUT, 1024, (j & 3) * 128, (j >> 2) * 128, (j >> 2) * 128, tile, tid); }
        else if (t < J5) { const int j = t - J4; ttile128(w_gate, DFF, g_pre_ffn, BTG, 1024, (j & 7) * 128, (j >> 3) * 128, (j >> 3) * 256, tile, tid); }
        else if (t < J6) { const int j = t - J5; ttile128(w_up, DFF, g_pre_ffn, BTG, 1024, (j & 7) * 128, (j >> 3) * 128, (j >> 3) * 256 + 128, tile, tid); }
        else if (t < J7) { const int j = t - J6; ttile128(w_down, 1024, nullptr, BTD, DFF, (j % 22) * 128, (j / 22) * 128, (j / 22) * 128, tile, tid); }
        else if (t < J8) { const int j = t - J7; ttile(SrcQ{w_uq, g_q}, BT2Q, 256, (j & 3) * 64, (j >> 2) * 64, tile); }
        else { const int j = t - J8; ttile(SrcKR{w_in, x_in}, BT1 + (size_t)1536 * 1024, 1024, (j & 15) * 64, (j >> 4) * 64, tile); }
        if (hasrow) ROWS_FINISH();
    }
    { float* RCOS = (float*)(ws + W_RCOS); float* RSIN = (float*)(ws + W_RSIN); float* TW = (float*)(ws + W_TW);
      bf16_t* F1 = (bf16_t*)(ws + W_F1); bf16_t* F2A = (bf16_t*)(ws + W_F2A); bf16_t* F2B = (bf16_t*)(ws + W_F2B);
      constexpr int E0 = 8192 * 16, E1 = E0 + 8192, E2 = E1 + 128 * 128, E3 = E2 + 128 * 256, E4 = E3 + 64 * 128;
      for (int e = b * 512 + tid; e < E4; e += G * 512) {
          if (e < E0) { const int pos = e >> 4, j = e & 15; const float inv = powf(10000.0f, -(float)j * (1.0f / 16.0f)); const float ang = (float)pos * inv; float s, c; sincosf(ang, &s, &c); RCOS[e] = c; RSIN[e] = s; }
          else if (e < E1) { const int m = e - E0; float s, c; sincospif((float)m * (1.0f / 4096.0f), &s, &c); TW[2 * m] = c; TW[2 * m + 1] = s; }
          else if (e < E2) { const int i = e - E1, mm = i >> 7, kx = i & 127, k1 = mm >> 1, ro = mm & 1, n1 = kx >> 1, ri = kx & 1; float s, c; sincospif((float)((n1 * k1) & 63) * (1.0f / 32.0f), &s, &c);
              const float v = (ro == ri) ? c : (ro == 0 ? s : -s); F1[i] = f2bf(v * 0.125f); }
          else if (e < E3) { const int i = e - E2, k2 = i >> 8, kx = i & 255, n2 = kx >> 1, ri = kx & 1; float s, c; sincospif((float)((n2 * k2) & 127) * (1.0f / 64.0f), &s, &c); F2A[i] = f2bf((ri ? s : c) * 0.08838834764831845f); }
          else { const int i = e - E3, k2 = i >> 7, kx = i & 127, n2 = kx >> 1, ri = kx & 1; float s, c; sincospif((float)((n2 * k2) & 63) * (1.0f / 32.0f), &s, &c); F2B[i] = f2bf((ri ? s : c) * 0.125f); }
      } }
    for (; rowA < MT;) { ROWS_LOAD(); ROWS_FINISH(); }
#undef ROWS_LOAD
#undef ROWS_FINISH
}

__device__ __forceinline__ void ffn_weight_tiles(KP p, unsigned char* shm) {
    KP_OPAQUE(p); int tid_ = threadIdx.x; asm volatile("" : "+v"(tid_));
    const int tid = tid_, G = gridDim.x, b = blockIdx.x, half = G / 2 > 0 ? G / 2 : 1; unsigned char* ws = p->ws; float* tile = (float*)shm;
    const float *g_pre_ffn = p->in[11], *w_gate = p->in[12], *w_up = p->in[13], *w_down = p->in[16]; bf16_t *BTG = (bf16_t*)(ws + W_BTG), *BTD = (bf16_t*)(ws + W_BTD);
    __syncthreads();
    for (int t = b - half; t >= 0 && t < 528; t += half) {
        if (t < 176) { const int j = t; ttile128(w_gate, DFF, g_pre_ffn, BTG, 1024, (j & 7) * 128, (j >> 3) * 128, (j >> 3) * 256, tile, tid); }
        else if (t < 352) { const int j = t - 176; ttile128(w_up, DFF, g_pre_ffn, BTG, 1024, (j & 7) * 128, (j >> 3) * 128, (j >> 3) * 256 + 128, tile, tid); }
        else { const int j = t - 352; ttile128(w_down, 1024, nullptr, BTD, DFF, (j % 22) * 128, (j / 22) * 128, (j / 22) * 128, tile, tid); } }
}

__device__ __forceinline__ void load_x1(KP p, const unsigned char* ws, int row, int lane, const f32x4 (&gpm)[4], f32x4 (&x1)[4]) {
    const float* xr = row < NPR ? p->in[0] + (size_t)row * DM : p->in[1] + (size_t)(row - NPR) * DM;
    const bf16_t* mr = (const bf16_t*)(ws + W_MIX) + (size_t)row * DM; const float* ssp = (const float*)(ws + W_SS2) + (size_t)row * 16;
    const f32x4 s0 = *(const f32x4*)ssp, s1 = *(const f32x4*)(ssp + 4), s2 = *(const f32x4*)(ssp + 8), s3 = *(const f32x4*)(ssp + 12); const f32x4 st = (s0 + s1) + (s2 + s3);
    const float rm = rsqrtf(((st[0] + st[1]) + (st[2] + st[3])) * (1.0f / 1024.0f) + EPS);
#pragma unroll
    for (int j = 0; j < 4; ++j) { const f32x4 xv = __builtin_nontemporal_load((const f32x4*)(xr + j * 256 + lane * 4)); const u32x2 mw = __builtin_nontemporal_load((const u32x2*)(mr + j * 256 + lane * 4));
        const f32x4 mv = {bflo(mw.x), bfhi(mw.x), bflo(mw.y), bfhi(mw.y)}; x1[j] = xv + mv * rm * gpm[j]; }
}
__device__ __forceinline__ void phase5(KP p, int row_lo, int row_hi, int blk_lo, int nblk) {
    int tid_ = threadIdx.x; asm volatile("" : "+v"(tid_));
    const int tid = tid_, lane = tid & 63, wid = tid >> 6, b = (int)blockIdx.x - blk_lo, G = nblk; unsigned char* ws = p->ws;
    if (b < 0 || b >= nblk) return;
    f32x4 gpm[4];
#pragma unroll
    for (int j = 0; j < 4; ++j) gpm[j] = *(const f32x4*)(p->in[10] + j * 256 + lane * 4);
    bf16_t* XB1 = (bf16_t*)(ws + W_XB); float* R2 = (float*)(ws + W_R2);
    for (int row0 = row_lo + b * 8 + wid; row0 < row_hi; row0 += 2 * G * 8) {
        const int row1 = row0 + G * 8 < row_hi ? row0 + G * 8 : row0;
        f32x4 xa[4], xb[4]; load_x1(p, ws, row0, lane, gpm, xa); load_x1(p, ws, row1, lane, gpm, xb); float sa = 0.f, sb = 0.f;
#pragma unroll
        for (int j = 0; j < 4; ++j) { sa += (xa[j][0] * xa[j][0] + xa[j][1] * xa[j][1]) + (xa[j][2] * xa[j][2] + xa[j][3] * xa[j][3]); sb += (xb[j][0] * xb[j][0] + xb[j][1] * xb[j][1]) + (xb[j][2] * xb[j][2] + xb[j][3] * xb[j][3]); }
        sa = wave_sum(sa); sb = wave_sum(sb);
        if (lane == 0) { R2[row0] = rsqrtf(sa * (1.0f / 1024.0f) + EPS); R2[row1] = rsqrtf(sb * (1.0f / 1024.0f) + EPS); }
#pragma unroll
        for (int j = 0; j < 4; ++j) { u32x2 w; w.x = cvtpk(xa[j][0], xa[j][1]); w.y = cvtpk(xa[j][2], xa[j][3]); *(u32x2*)(XB1 + (size_t)row0 * DM + j * 256 + lane * 4) = w;
            u32x2 v; v.x = cvtpk(xb[j][0], xb[j][1]); v.y = cvtpk(xb[j][2], xb[j][3]); *(u32x2*)(XB1 + (size_t)row1 * DM + j * 256 + lane * 4) = v; }
    }
}
__device__ __forceinline__ void phase9(KP p) {
    int tid_ = threadIdx.x; asm volatile("" : "+v"(tid_));
    const int tid = tid_, lane = tid & 63, wid = tid >> 6, G = gridDim.x, b = blockIdx.x; unsigned char* ws = p->ws;
    f32x4 gpf[4];
#pragma unroll
    for (int j = 0; j < 4; ++j) gpf[j] = *(const f32x4*)(p->in[17] + j * 256 + lane * 4);
    const bf16_t* XB1 = (const bf16_t*)(ws + W_XB); const bf16_t* FFN = (const bf16_t*)(ws + W_MIX); const float* SS3 = (const float*)(ws + W_SS3);
    for (int row0 = b * 8 + wid; row0 < MT; row0 += 2 * G * 8) {
        const int rows[2] = {row0, row0 + G * 8 < MT ? row0 + G * 8 : row0};
        u32x2 xw[2][4], fw[2][4]; f32x4 st[2];
#pragma unroll
        for (int q = 0; q < 2; ++q) { const float* ssp = SS3 + (size_t)rows[q] * 16; const f32x4 s0 = *(const f32x4*)ssp, s1 = *(const f32x4*)(ssp + 4), s2 = *(const f32x4*)(ssp + 8), s3 = *(const f32x4*)(ssp + 12); st[q] = (s0 + s1) + (s2 + s3);
#pragma unroll
            for (int j = 0; j < 4; ++j) { xw[q][j] = __builtin_nontemporal_load((const u32x2*)(XB1 + (size_t)rows[q] * DM + j * 256 + lane * 4)); fw[q][j] = __builtin_nontemporal_load((const u32x2*)(FFN + (size_t)rows[q] * DM + j * 256 + lane * 4)); } }
#pragma unroll
        for (int q = 0; q < 2; ++q) { const float rf = rsqrtf(((st[q][0] + st[q][1]) + (st[q][2] + st[q][3])) * (1.0f / 1024.0f) + EPS);
#pragma unroll
            for (int j = 0; j < 4; ++j) { const f32x4 xv = {bflo(xw[q][j].x), bfhi(xw[q][j].x), bflo(xw[q][j].y), bfhi(xw[q][j].y)}, fv = {bflo(fw[q][j].x), bfhi(fw[q][j].x), bflo(fw[q][j].y), bfhi(fw[q][j].y)};
                __builtin_nontemporal_store(xv + fv * rf * gpf[j], (f32x4*)(p->out + (size_t)rows[q] * DM + j * 256 + lane * 4)); } }
    }
}

__device__ __forceinline__ int crow(int r, int hi) { return (r & 3) + 8 * (r >> 2) + 4 * hi; }
__device__ __forceinline__ bf16x8 ldsB(const unsigned* T, int r0, int n) { u32x4 w = {T[(r0 + 0) * 128 + n], T[(r0 + 1) * 128 + n], T[(r0 + 2) * 128 + n], T[(r0 + 3) * 128 + n]}; return *reinterpret_cast<bf16x8*>(&w); }
__device__ __forceinline__ void fft1_decode(int it, int& chb, int& seqbase, int& N2, int& n2, int& tws) {
    chb = it & 3; const int sn = it >> 2;
    if (sn < 256) { seqbase = (sn >> 7) * 8192; N2 = 128; n2 = sn & 127; tws = 1; } else { const int s2 = sn - 256; seqbase = NPR + (s2 >> 6) * 4096; N2 = 64; n2 = s2 & 63; tws = 2; }
}
__device__ __forceinline__ void fft_stage1(KP p, unsigned char* shm) {
    int tid_ = threadIdx.x; asm volatile("" : "+v"(tid_));
    const int tid = tid_, lane = tid & 63, wid = __builtin_amdgcn_readfirstlane(tid >> 6), l32 = lane & 31, hi = lane >> 5, G = gridDim.x; unsigned char* ws = p->ws;
    const unsigned* VC = (const unsigned*)(ws + W_VC); unsigned* T1 = (unsigned*)(ws + W_XB); const bf16_t* F1 = (const bf16_t*)(ws + W_F1); const float* TW = (const float*)(ws + W_TW);
    unsigned* T = (unsigned*)shm;
    const int mb = wid & 3, cb0 = (wid >> 2) * 2;
    bf16x8 a[8];
#pragma unroll
    for (int ks = 0; ks < 8; ++ks) a[ks] = *(const bf16x8*)(F1 + (32 * mb + l32) * 128 + 16 * ks + 8 * hi);
    u32x4 pre[4];
#define F1_LOAD(it_) do { int chb_, sb_, N2_, n2_, tw_; fft1_decode(it_, chb_, sb_, N2_, n2_, tw_); _Pragma("unroll") for (int i = 0; i < 4; ++i) { const int idx = tid + 512 * i, r = idx >> 5, c4 = idx & 31; \
        pre[i] = *(const u32x4*)(VC + (size_t)(sb_ + N2_ * r + n2_) * 512 + chb_ * 128 + c4 * 4); } } while (0)
    if ((int)blockIdx.x < 2048) F1_LOAD((int)blockIdx.x);
    for (int it = blockIdx.x; it < 2048; it += G) {
        int chb, seqbase, N2, n2, tws; fft1_decode(it, chb, seqbase, N2, n2, tws);
        __syncthreads();
#pragma unroll
        for (int i = 0; i < 4; ++i) { const int idx = tid + 512 * i, r = idx >> 5, c4 = idx & 31; *(u32x4*)(T + r * 128 + c4 * 4) = pre[i]; }
        __syncthreads();
        if (it + G < 2048) F1_LOAD(it + G);
#pragma unroll
        for (int c = 0; c < 2; ++c) { const int n = 32 * (cb0 + c) + l32; f32x16 acc = {};
#pragma unroll
            for (int ks = 0; ks < 8; ++ks) acc = __builtin_amdgcn_mfma_f32_32x32x16_bf16(a[ks], ldsB(T, 8 * ks + 4 * hi, n), acc, 0, 0, 0);
#pragma unroll
            for (int q = 0; q < 4; ++q)
#pragma unroll
                for (int e = 0; e < 2; ++e) { const int k1 = 16 * mb + 4 * q + 2 * hi + e; const float re = acc[4 * q + 2 * e], im = acc[4 * q + 2 * e + 1];
                    const int ti = (n2 * k1 * tws) & 8191; const float cc = TW[2 * ti], sn_ = TW[2 * ti + 1];
                    T1[(size_t)(seqbase + k1 * N2 + n2) * 512 + chb * 128 + n] = cvtpk(re * cc + im * sn_, im * cc - re * sn_); } }
    }
#undef F1_LOAD
    __syncthreads();
}
template <int N2> __device__ __forceinline__ void fft_stage2_loop(KP p, unsigned* T, int it0, int it_end, int tid, int wid, int l32, int hi) {
    unsigned char* ws = p->ws; const unsigned* T1 = (const unsigned*)(ws + W_XB); bf16_t* AF = (bf16_t*)(ws + W_AF);
    const bf16_t* F2 = (const bf16_t*)(ws + (N2 == 128 ? W_F2A : W_F2B)); const int G = gridDim.x;
    constexpr int NL = N2 / 16, NMB = N2 / 32, NCB = (N2 == 128) ? 2 : 1, KS = N2 / 8;
    const int mb = wid & (NMB - 1), cbase = (N2 == 128) ? (wid >> 2) * 2 : (wid >> 1);
    u32x4 pre[NL];
#define F2_LOAD(it_) do { const int chb_ = (it_) & 3, k1_ = ((it_) >> 2) & 63, sq_ = (it_) >> 8, sb_ = (N2 == 128) ? sq_ * 8192 : NPR + (sq_ - 2) * 4096; _Pragma("unroll") for (int i = 0; i < NL; ++i) { const int idx = tid + 512 * i, r = idx >> 5, c4 = idx & 31; \
        pre[i] = *(const u32x4*)(T1 + (size_t)(sb_ + k1_ * N2 + r) * 512 + chb_ * 128 + c4 * 4); } } while (0)
    if (it0 < it_end) F2_LOAD(it0);
    for (int it = it0; it < it_end; it += G) { const int chb = it & 3, k1 = (it >> 2) & 63, sq = it >> 8, seqbase = (N2 == 128) ? sq * 8192 : NPR + (sq - 2) * 4096;
        __syncthreads();
#pragma unroll
        for (int i = 0; i < NL; ++i) { const int idx = tid + 512 * i, r = idx >> 5, c4 = idx & 31; *(u32x4*)(T + r * 128 + c4 * 4) = pre[i]; }
        __syncthreads();
        if (it + G < it_end) F2_LOAD(it + G);
#pragma unroll
        for (int c = 0; c < NCB; ++c) { const int n = 32 * (cbase + c) + l32; f32x16 acc = {};
#pragma unroll
            for (int ks = 0; ks < KS; ++ks) { const bf16x8 a = *(const bf16x8*)(F2 + (32 * mb + l32) * (2 * N2) + 16 * ks + 8 * hi);
                acc = __builtin_amdgcn_mfma_f32_32x32x16_bf16(a, ldsB(T, 8 * ks + 4 * hi, n), acc, 0, 0, 0); }
#pragma unroll
            for (int r = 0; r < 16; ++r) { const int k2 = 32 * mb + crow(r, hi); AF[(size_t)(seqbase + k1 + 64 * k2) * 1024 + 512 + chb * 128 + n] = f2bf(acc[r]); } }
    }
#undef F2_LOAD
    __syncthreads();
}
__device__ __forceinline__ void fft_stage2(KP p, unsigned char* shm) {
    int tid_ = threadIdx.x; asm volatile("" : "+v"(tid_));
    const int tid = tid_, lane = tid & 63, wid = __builtin_amdgcn_readfirstlane(tid >> 6), l32 = lane & 31, hi = lane >> 5, G = gridDim.x;
    unsigned* T = (unsigned*)shm;
    __syncthreads();
    fft_stage2_loop<128>(p, T, (int)blockIdx.x, 512, tid, wid, l32, hi);
    { int it0 = blockIdx.x; while (it0 < 512) it0 += G; fft_stage2_loop<64>(p, T, it0, 1536, tid, wid, l32, hi); }
}

namespace att {
constexpr int KVBLK = 64, SHM_V = 8192, SHM_K = 16384;
constexpr float THRL = 11.5f;
#define KSWZ(row, colB) ((row) * 256 + ((colB) ^ (((row) & 15) << 4)))
#define SBAR() __builtin_amdgcn_sched_barrier(0)
template <bool FIRST> __device__ __forceinline__ void partialSM(f32x16& p0, f32x16& p1, float& m_reg, float& alpha) {
    float pmax = p0[0];
#pragma unroll
    for (int r = 1; r < 16; ++r) pmax = fmaxf(pmax, p0[r]);
#pragma unroll
    for (int r = 0; r < 16; ++r) pmax = fmaxf(pmax, p1[r]);
    { auto rr = __builtin_amdgcn_permlane32_swap(__float_as_uint(pmax), __float_as_uint(pmax), false, false); pmax = fmaxf(__uint_as_float(rr[0]), __uint_as_float(rr[1])); }
    if (!FIRST && __builtin_expect(__all(pmax <= THRL), 1)) { alpha = 1.f; }
    else { const float d = FIRST ? pmax : fmaxf(pmax, 0.f); alpha = FIRST ? 1.f : __builtin_amdgcn_exp2f(-d); m_reg += d;
#pragma unroll
        for (int r = 0; r < 16; ++r) p0[r] = p0[r] - d;
#pragma unroll
        for (int r = 0; r < 16; ++r) p1[r] = p1[r] - d; }
#pragma unroll
    for (int r = 0; r < 16; ++r) p0[r] = __builtin_amdgcn_exp2f(p0[r]);
}
__device__ __forceinline__ void finishSM(f32x16& p0, f32x16& p1, float alpha, float& l_reg, bf16x8& pa0, bf16x8& pa1, bf16x8& pa2, bf16x8& pa3) {
#pragma unroll
    for (int r = 0; r < 16; ++r) p1[r] = __builtin_amdgcn_exp2f(p1[r]);
    float ps = 0;
#pragma unroll
    for (int r = 0; r < 16; ++r) ps += p0[r];
#pragma unroll
    for (int r = 0; r < 16; ++r) ps += p1[r];
    { auto rr = __builtin_amdgcn_permlane32_swap(__float_as_uint(ps), __float_as_uint(ps), false, false); ps = __uint_as_float(rr[0]) + __uint_as_float(rr[1]); }
    l_reg = l_reg * alpha + ps;
#define PK4(P, BASE, OUT) do { unsigned a0 = cvtpk(P[BASE + 0], P[BASE + 1]), a1 = cvtpk(P[BASE + 2], P[BASE + 3]);   \
    unsigned b0 = cvtpk(P[BASE + 4], P[BASE + 5]), b1 = cvtpk(P[BASE + 6], P[BASE + 7]);                              \
    auto r0 = __builtin_amdgcn_permlane32_swap(a0, b0, false, false); auto r1 = __builtin_amdgcn_permlane32_swap(a1, b1, false, false); \
    u32x4 w = {r0[0], r1[0], r0[1], r1[1]}; OUT = *reinterpret_cast<bf16x8*>(&w); } while (0)
    PK4(p0, 0, pa0); PK4(p0, 8, pa1); PK4(p1, 0, pa2); PK4(p1, 8, pa3);
#undef PK4
}
__device__ __forceinline__ void qkt(f32x16& p0, f32x16& p1, const char* Ks, const bf16x8* qr, int r32, int hi, float minit) {
#pragma unroll
    for (int r = 0; r < 16; ++r) { p0[r] = minit; p1[r] = minit; }
#pragma unroll
    for (int d0 = 0; d0 < 6; ++d0) { const int cb = (d0 * 16 + hi * 8) * 2;
        bf16x8 b0 = *reinterpret_cast<const bf16x8*>(Ks + KSWZ(r32, cb));
        bf16x8 b1 = *reinterpret_cast<const bf16x8*>(Ks + KSWZ(32 + r32, cb));
        p0 = __builtin_amdgcn_mfma_f32_32x32x16_bf16(b0, qr[d0], p0, 0, 0, 0);
        p1 = __builtin_amdgcn_mfma_f32_32x32x16_bf16(b1, qr[d0], p1, 0, 0, 0); }
}
__device__ __forceinline__ int v_st(int k, int c) { const int kk = (k & ~0xC) | ((k & 4) << 1) | ((k & 8) >> 1); return ((kk >> 3) * 2 + (c >> 5)) * 512 + ((kk & 7) * 32 + (c & 31)) * 2; }
__device__ __forceinline__ int v_rd_base(int lane) { return ((lane & 3) << 3) | (((lane >> 2) & 3) << 6) | (((lane >> 4) & 1) << 5) | (((lane >> 5) & 1) << 8); }
constexpr int v_rd_off(int d0, int ks, int half) { return d0 * 512 + ks * 2048 + half * 1024; }
template <int OFF> __device__ __forceinline__ s16x4 tr_read(int vb) { s16x4 r; asm volatile("ds_read_b64_tr_b16 %0, %1 offset:%2" : "=&v"(r) : "v"(vb), "i"(OFF) : "memory"); return r; }
template <int D0> __device__ __forceinline__ void pv_one(f32x16& od, int vb, bf16x8 pa0, bf16x8 pa1, bf16x8 pa2, bf16x8 pa3) {
    const s16x4 l0 = tr_read<v_rd_off(D0, 0, 0)>(vb), h0 = tr_read<v_rd_off(D0, 0, 1)>(vb), l1 = tr_read<v_rd_off(D0, 1, 0)>(vb), h1 = tr_read<v_rd_off(D0, 1, 1)>(vb);
    const s16x4 l2 = tr_read<v_rd_off(D0, 2, 0)>(vb), h2 = tr_read<v_rd_off(D0, 2, 1)>(vb), l3 = tr_read<v_rd_off(D0, 3, 0)>(vb), h3 = tr_read<v_rd_off(D0, 3, 1)>(vb);
    asm volatile("s_waitcnt lgkmcnt(0)" ::: "memory"); SBAR();
#define PK(L, H) (bf16x8){L[0], L[1], L[2], L[3], H[0], H[1], H[2], H[3]}
    od = __builtin_amdgcn_mfma_f32_32x32x16_bf16(pa0, PK(l0, h0), od, 0, 0, 0);
    od = __builtin_amdgcn_mfma_f32_32x32x16_bf16(pa1, PK(l1, h1), od, 0, 0, 0);
    od = __builtin_amdgcn_mfma_f32_32x32x16_bf16(pa2, PK(l2, h2), od, 0, 0, 0);
    od = __builtin_amdgcn_mfma_f32_32x32x16_bf16(pa3, PK(l3, h3), od, 0, 0, 0);
#undef PK
}
__device__ __forceinline__ void pv_d0(f32x16* o, int vb, bf16x8 pa0, bf16x8 pa1, bf16x8 pa2, bf16x8 pa3) { pv_one<0>(o[0], vb, pa0, pa1, pa2, pa3); pv_one<1>(o[1], vb, pa0, pa1, pa2, pa3); }

__device__ __forceinline__ void body(const bf16_t* __restrict__ Qb, const bf16_t* __restrict__ KNh, const bf16_t* __restrict__ KRs, const bf16_t* __restrict__ Vh, bf16_t* __restrict__ Ob, int seq, char* lds, int qpos0, const float* RCOS, const float* RSIN) {
    int tid_ = threadIdx.x; asm volatile("" : "+v"(tid_));
    const int tid = tid_, wid = __builtin_amdgcn_readfirstlane(tid >> 6), lane = tid & 63, r32 = lane & 31, hi = lane >> 5;
    char* V_lds = lds; char* K_lds = lds + 3 * SHM_V;
    float* wsf = (float*)(lds + 3 * SHM_V + 3 * SHM_K) + wid * 64; float* li_l = wsf; float* al_l = wsf + 32;
    float m_reg = 0.f, l_reg = 0; f32x16 o[2] = {}; bf16x8 qr[6];
    const bf16_t* Qw = Qb + (size_t)(wid * 32 + r32) * 96 + hi * 8;
#pragma unroll
    for (int d0 = 0; d0 < 6; ++d0) qr[d0] = *(const bf16x8*)(Qw + d0 * 16);
#pragma unroll
    for (int d0 = 4; d0 < 6; ++d0) { const int i4 = (2 * (d0 - 4) + hi) * 4, pos = qpos0 + wid * 32 + r32; const f32x4 c4 = *(const f32x4*)(RCOS + pos * 16 + i4), s4 = *(const f32x4*)(RSIN + pos * 16 + i4);
        const u32x4 w = *reinterpret_cast<const u32x4*>(&qr[d0]); const f32x4 x1 = {bflo(w.x), bfhi(w.x), bflo(w.y), bfhi(w.y)}, x2 = {bflo(w.z), bfhi(w.z), bflo(w.w), bfhi(w.w)};
        const u32x4 o = pack8(x1 * c4 - x2 * s4, x2 * c4 + x1 * s4); qr[d0] = *reinterpret_cast<const bf16x8*>(&o); }
    const int vr = tid >> 3, vc = (tid & 7) * 8, vst = v_st(vr, vc);
    const char* vp = (const char*)(Vh + (size_t)vr * 64 + vc);
    const int cA = tid, rA = cA / 12, pA = cA - rA * 12; const int cB = 512 + (tid & 255), rB = cB / 12, pB = cB - rB * 12;
    const char* kpA = pA < 8 ? (const char*)(KNh + (size_t)rA * 64 + pA * 8) : (const char*)(KRs + (size_t)rA * 32 + (pA - 8) * 8); const size_t ksA = pA < 8 ? 8192 : 4096; const int kdA = KSWZ(rA, pA * 16);
    const bool hasB = wid < 4;
    const char* kpB = !hasB ? kpA : (pB < 8 ? (const char*)(KNh + (size_t)rB * 64 + pB * 8) : (const char*)(KRs + (size_t)rB * 32 + (pB - 8) * 8)); const size_t ksB = !hasB ? ksA : (pB < 8 ? 8192 : 4096); const int kdB = !hasB ? kdA : KSWZ(rB, pB * 16);
    const int vb0 = (int)(uintptr_t)V_lds + v_rd_base(lane);
    struct { bf16x8 vs, ka, kb; } sr_[2];
#define SLOAD(i, j) do { sr_[i].vs = *(const bf16x8*)(vp + (size_t)(j) * 8192); sr_[i].ka = *(const bf16x8*)(kpA + (size_t)(j) * ksA); sr_[i].kb = *(const bf16x8*)(kpB + (size_t)(j) * ksB); } while (0)
#define SWRITE(b, i) do { *(bf16x8*)(V_lds + (b) * SHM_V + vst) = sr_[i].vs; *(bf16x8*)(K_lds + (b) * SHM_K + kdA) = sr_[i].ka; *(bf16x8*)(K_lds + (b) * SHM_K + kdB) = sr_[i].kb; } while (0)
#define RESC(a) do { if (__any((a) < 1.f)) { if (hi == 0) al_l[r32] = (a); asm volatile("s_waitcnt lgkmcnt(0)" ::: "memory"); \
    _Pragma("unroll") for (int d = 0; d < 2; ++d) _Pragma("unroll") for (int r = 0; r < 16; ++r) o[d][r] *= al_l[crow(r, hi)]; } } while (0)
#define NEXT3(x) ((x) == 2 ? 0 : (x) + 1)
    f32x16 pA0, pA1, pB0, pB1; float alA, alB; bf16x8 pa0, pa1, pa2, pa3; const int NT = seq / KVBLK;
    __syncthreads();
    SLOAD(0, 0); SLOAD(1, 1); asm volatile("s_waitcnt vmcnt(3)" ::: "memory"); SWRITE(0, 0); SLOAD(0, 2);
    __syncthreads();
    qkt(pA0, pA1, K_lds, qr, r32, hi, 0.f); partialSM<true>(pA0, pA1, m_reg, alA);
    SWRITE(1, 1); SLOAD(1, 3);
    int bc = 1;
    for (int j = 1; j + 1 < NT; j += 2) {
        { const int bn = NEXT3(bc), bp = (bc == 0 ? 2 : bc - 1);
          __syncthreads();
          SBAR(); qkt(pB0, pB1, K_lds + bc * SHM_K, qr, r32, hi, -m_reg);
          finishSM(pA0, pA1, alA, l_reg, pa0, pa1, pa2, pa3); SBAR();
          pv_d0(o, vb0 + bp * SHM_V, pa0, pa1, pa2, pa3); partialSM<false>(pB0, pB1, m_reg, alB);
          SBAR(); SWRITE(bn, 0); SLOAD(0, (j + 3 < NT ? j + 3 : NT - 1));
          RESC(alB); bc = bn; }
        { const int bn = NEXT3(bc), bp = (bc == 0 ? 2 : bc - 1);
          __syncthreads();
          SBAR(); qkt(pA0, pA1, K_lds + bc * SHM_K, qr, r32, hi, -m_reg);
          finishSM(pB0, pB1, alB, l_reg, pa0, pa1, pa2, pa3); SBAR();
          pv_d0(o, vb0 + bp * SHM_V, pa0, pa1, pa2, pa3); partialSM<false>(pA0, pA1, m_reg, alA);
          SBAR(); SWRITE(bn, 1); SLOAD(1, (j + 4 < NT ? j + 4 : NT - 1));
          RESC(alA); bc = bn; }
    }
    { const int bp = (bc == 0 ? 2 : bc - 1);
      __syncthreads();
      SBAR(); qkt(pB0, pB1, K_lds + bc * SHM_K, qr, r32, hi, -m_reg);
      finishSM(pA0, pA1, alA, l_reg, pa0, pa1, pa2, pa3); SBAR();
      pv_d0(o, vb0 + bp * SHM_V, pa0, pa1, pa2, pa3); partialSM<false>(pB0, pB1, m_reg, alB);
      RESC(alB);
      finishSM(pB0, pB1, alB, l_reg, pa0, pa1, pa2, pa3); SBAR();
      pv_d0(o, vb0 + bc * SHM_V, pa0, pa1, pa2, pa3); }
    asm volatile("s_waitcnt vmcnt(0)" ::: "memory");
    if (hi == 0) li_l[r32] = l_reg; asm volatile("s_waitcnt lgkmcnt(0)" ::: "memory");
    float rli[16];
#pragma unroll
    for (int r = 0; r < 16; ++r) rli[r] = __builtin_amdgcn_rcpf(li_l[crow(r, hi)]);
    bf16_t* Ow = Ob + (size_t)(wid * 32) * 1024;
#pragma unroll
    for (int r = 0; r < 16; ++r) { const int orow = crow(r, hi);
#pragma unroll
        for (int d0 = 0; d0 < 2; ++d0) Ow[(size_t)orow * 1024 + d0 * 32 + r32] = f2bf(o[d0][r] * rli[r]); }
#undef SLOAD
#undef SWRITE
#undef RESC
#undef NEXT3
}
}

__device__ __forceinline__ void attn_phase(KP p, unsigned char* shm) {
    const int G = gridDim.x, b = blockIdx.x; unsigned char* ws = p->ws; unsigned char* od = (unsigned char*)p->out;
    const bf16_t* Q = (const bf16_t*)(od + O_Q); const bf16_t* KN = (const bf16_t*)(od + O_KN); const bf16_t* VV = (const bf16_t*)(od + O_VV); const bf16_t* KRP = (const bf16_t*)(ws + W_KRP); bf16_t* AF = (bf16_t*)(ws + W_AF);
    for (int it = b; it < 1024; it += G) {
        int pair, qb, seqbase, len, head;
        if (G == 256) { const int j = it >> 8, xcd = b & 7, slot = b >> 3;
            if (j < 2) { pair = j * 8 + xcd; qb = slot; seqbase = (pair >> 3) * 8192; len = 8192; }
            else { pair = (j - 2) * 16 + 2 * xcd + (slot >> 4); qb = slot & 15; seqbase = NPR + (pair >> 3) * 4096; len = 4096; }
        } else if (it < 512) { pair = it >> 5; qb = it & 31; seqbase = (pair >> 3) * 8192; len = 8192; }
        else { const int i2 = it - 512; pair = i2 >> 4; qb = i2 & 15; seqbase = NPR + (pair >> 3) * 4096; len = 4096; }
        head = pair & 7;
        att::body(Q + ((size_t)head * MT + seqbase + qb * 256) * 96, KN + ((size_t)head * MT + seqbase) * 64, KRP + (size_t)seqbase * 32, VV + ((size_t)head * MT + seqbase) * 64,
                  AF + (size_t)(seqbase + qb * 256) * 1024 + head * 64, len, (char*)shm, qb * 256, (const float*)(ws + W_RCOS), (const float*)(ws + W_RSIN));
    }
}


#ifndef DBG_STOP
#define DBG_STOP 0
#endif
__device__ __forceinline__ float bfv(const bf16_t* p, size_t i) { return __uint_as_float(((unsigned)p[i]) << 16); }
__device__ __forceinline__ void dbg_probe(KP p, int k) {
    unsigned char* ws = p->ws; float* out = p->out; const size_t n = (size_t)MT * DM;
    for (size_t i = (size_t)blockIdx.x * 512 + threadIdx.x; i < n; i += (size_t)gridDim.x * 512) { const size_t row = i >> 10; const int c = (int)(i & 1023); float v = 0.f;
        if (k == 1) v = bfv((const bf16_t*)(ws + W_VC), i) + bfv((const bf16_t*)(ws + W_CQ), row * 256 + (c & 255)) + bfv((const bf16_t*)(ws + W_CKV), row * 256 + (c & 255)) + bfv((const bf16_t*)(ws + W_KRP), row * 32 + (c & 31)) + ((const float*)(ws + W_SSP))[row * 8 + (c & 7)];
        if (k == 10) v = bfv((const bf16_t*)(ws + W_XB), i) + ((const float*)(ws + W_RX))[row];
        if (k == 11) v = bfv((const bf16_t*)(ws + W_BT1), i) + bfv((const bf16_t*)(ws + W_BTOUT), i) + bfv((const bf16_t*)(ws + W_BTG), i % ((size_t)DFF * 1024)) + bfv((const bf16_t*)(ws + W_BTD), i % ((size_t)DFF * 1024)) + bfv((const bf16_t*)(ws + W_BT2Q), i % (768 * 256)) + ((const float*)(ws + W_RCOS))[i % (8192 * 16)] + ((const float*)(ws + W_TW))[i % 16384] + bfv((const bf16_t*)(ws + W_F2A), i % 32768);
        if (k == 2) v = bfv((const bf16_t*)(ws + W_XB), i);
        if (k == 3) v = bfv((const bf16_t*)(ws + W_AF), i);
        if (k == 4) v = bfv((const bf16_t*)(ws + W_MIX), i) + ((const float*)(ws + W_SS2))[row * 16 + (c & 15)];
        if (k == 5) v = bfv((const bf16_t*)(ws + W_XB), i) + ((const float*)(ws + W_R2))[row];
        if (k == 8) v = bfv((const bf16_t*)(ws + W_XB), i) + ((const float*)(ws + W_SS3))[row * 16 + (c & 15)];
        out[i] = v; }
}
__device__ __forceinline__ void dbg_probe_qkv(KP p, int step) {
    unsigned char* ws = p->ws; float* out = p->out; const size_t n = (size_t)MT * DM; float* tmp = (float*)(ws + 96 * MiB); const unsigned char* od = (const unsigned char*)p->out;
    for (size_t i = (size_t)blockIdx.x * 512 + threadIdx.x; i < n; i += (size_t)gridDim.x * 512) {
        if (step == 0) { float v = bfv((const bf16_t*)od, i); if (i < (size_t)24 * 1048576) v += bfv((const bf16_t*)(od + 64 * MiB), i); tmp[i] = v; }
        else out[i] = tmp[i]; }
}
#define XB_TMO      128
#define XB_XCNT(j)  (256  + 64 * (j))
#define XB_XSUB(j)  (1280 + 64 * (j))
#define XB_XGEN(j)  (2304 + 64 * (j))
#define XB_TOP      3328
#define XB_TOPGEN   3392
#define XCD_BAR_WORDS 3456
#define XB_SPIN_CAP (1u << 18)
#define XLAS __attribute__((address_space(3)))

__device__ __forceinline__ unsigned xb_ld(unsigned* p)              { return __hip_atomic_load(p, __ATOMIC_RELAXED, __HIP_MEMORY_SCOPE_AGENT); }
__device__ __forceinline__ unsigned xb_add(unsigned* p, unsigned v) { return __hip_atomic_fetch_add(p, v, __ATOMIC_RELAXED, __HIP_MEMORY_SCOPE_AGENT); }
__device__ __forceinline__ unsigned xb_xcc_id() { return (unsigned)__builtin_amdgcn_s_getreg((3 << 11) | 20) & 0xFu; }
#define XB_SPIN(cond, bar) do { unsigned _sp = 0; while (cond) { __builtin_amdgcn_s_sleep(1); \
    if ((++_sp & 255u) == 0u) { if (xb_ld(&(bar)[XB_TMO])) break; if (_sp > XB_SPIN_CAP) { atomicAdd(&(bar)[XB_TMO], 1u); break; } } } } while (0)

struct XcdBarrier {
    unsigned* bar; unsigned x;
    volatile XLAS unsigned* st;
};

__device__ __forceinline__ XcdBarrier xcd_barrier_post(unsigned* bar, volatile XLAS unsigned* st) {
    XcdBarrier b; b.bar = bar; b.x = xb_xcc_id(); b.st = st;
    if (threadIdx.x == 0) (void)xb_add(&bar[XB_XCNT(b.x)], 1u);
    return b;
}
__device__ __forceinline__ void xcd_barrier_complete(unsigned* bar, unsigned x, unsigned& nloc, unsigned& nx) {
    const unsigned G = gridDim.x * gridDim.y * gridDim.z;
    unsigned sum, cnt, mine, sp = 0u;
    for (;;) {
        sum = 0u; cnt = 0u; mine = 0u;
#pragma unroll
        for (unsigned j = 0; j < 16; ++j) { const unsigned c = xb_ld(&bar[XB_XCNT(j)]); sum += c; cnt += (c > 0u) ? 1u : 0u; mine = (j == x) ? c : mine; }
        if (sum == G) break;
        __builtin_amdgcn_s_sleep(1);
        if ((++sp & 255u) == 0u) { if (xb_ld(&bar[XB_TMO])) break; if (sp > XB_SPIN_CAP) { atomicAdd(&bar[XB_TMO], 1u); break; } }
    }
    nloc = mine > 0u ? mine : 1u; nx = cnt > 0u ? cnt : 1u;
}

__device__ __forceinline__ void xcd_barrier(const XcdBarrier& b) {
    asm volatile("s_waitcnt vmcnt(0)" ::: "memory");
    __syncthreads();
    if (threadIdx.x == 0) {
        unsigned* bar = b.bar;
        __builtin_amdgcn_s_waitcnt(0);
        unsigned nloc = b.st[0], nx = b.st[1];
        if (nloc == 0u) { xcd_barrier_complete(bar, b.x, nloc, nx); b.st[0] = nloc; b.st[1] = nx; }
        const unsigned old = xb_add(&bar[XB_XSUB(b.x)], 1u);
        const unsigned gen = old / nloc;
        if (old + 1u == (gen + 1u) * nloc) {
            __builtin_amdgcn_fence(__ATOMIC_RELEASE, "agent");
            asm volatile("s_waitcnt vmcnt(0)" ::: "memory");
            const unsigned og = xb_add(&bar[XB_TOP], 1u);
            const unsigned tg = og / nx;
            if (og + 1u == (tg + 1u) * nx) xb_add(&bar[XB_TOPGEN], 1u);
            else XB_SPIN(xb_ld(&bar[XB_TOPGEN]) == tg, bar);
            __builtin_amdgcn_fence(__ATOMIC_ACQUIRE, "agent");
            xb_add(&bar[XB_XGEN(b.x)], 1u);
            asm volatile("s_waitcnt vmcnt(0)" ::: "memory");
        } else {
            XB_SPIN(xb_ld(&bar[XB_XGEN(b.x)]) == gen, bar);
            __builtin_amdgcn_fence(__ATOMIC_ACQUIRE, "agent");
            asm volatile("s_waitcnt vmcnt(0)" ::: "memory");
        }
    }
    __syncthreads();
}

#ifndef OWN_BAR
#define OWN_BAR 1
#endif
#ifndef PHM
#define PHM 0xFFFF
#endif
#ifndef DUPM
#define DUPM 0
#endif
#define PH(n) for (int rep_ = 0; rep_ < 1 + ((DUPM >> (n)) & 1); ++rep_) if constexpr ((PHM >> (n)) & 1)
__global__ void __launch_bounds__(512) mega_fwd(Params p_unused) {
    extern __shared__ __attribute__((aligned(16))) unsigned char shm[];
#if !OWN_BAR
    cg::grid_group grid = cg::this_grid();
#endif
    PG8_LAS unsigned char* lds = (PG8_LAS unsigned char*)shm;
    const int G = gridDim.x, b = blockIdx.x;
    KP p = (KP)__builtin_amdgcn_kernarg_segment_ptr();

#define TSTAMP(k) do { if constexpr (DIAG_A >= 0) { if (blockIdx.x == 0 && threadIdx.x == 0) ((unsigned long long*)(p->ws + W_TS))[k] = wall_clock64(); } } while (0)
#if OWN_BAR
    if (threadIdx.x < 2) ((volatile XLAS unsigned*)(lds + 131072))[threadIdx.x] = 0u;
    __syncthreads();
    { KP_OPAQUE(p); (void)xcd_barrier_post((unsigned*)(p->ws + W_BAR), (volatile XLAS unsigned*)(lds + 131072)); }
#define GRID_SYNC(gen) do { XcdBarrier xb_; xb_.bar = (unsigned*)(p->ws + W_BAR); xb_.x = xb_xcc_id(); xb_.st = (volatile XLAS unsigned*)(lds + 131072); xcd_barrier(xb_); } while (0)
#else
#define GRID_SYNC(gen) do { asm volatile("s_waitcnt vmcnt(0) lgkmcnt(0)" ::: "memory"); grid.sync(); __builtin_amdgcn_fence(__ATOMIC_ACQUIRE, "agent"); asm volatile("s_waitcnt vmcnt(0)" ::: "memory"); } while (0)
#endif
    TSTAMP(0);
    PH(0) phase0(p, shm);
    GRID_SYNC(1); TSTAMP(1);
    if constexpr (DBG_STOP == 10 || DBG_STOP == 11) { dbg_probe(p, DBG_STOP); return; }
    PH(1) {
        KP_OPAQUE(p); unsigned char* ws = p->ws;
        pg8::Gemm g{(const bf16_t*)(ws + W_XB), (const bf16_t*)(ws + W_BT1), MT, 1792, 1024}; pg8::StaticOrder S; S.init(MT, 1792, G, b);
        Epi1 E{(const float*)(ws + W_RX), (bf16_t*)(ws + W_CQ), (bf16_t*)(ws + W_CKV), (float*)(ws + W_SSP), (bf16_t*)(ws + W_VC), (bf16_t*)(ws + W_KRP), (const float*)(ws + W_RCOS), (const float*)(ws + W_RSIN)};
        pg8::gemm_phase<Epi1, pg8::StaticOrder, GEMM_ALIGN, GEMM_SP2>(lds, g, S, E);
    }
    PH(1) { ffn_weight_tiles(p, shm); }
    GRID_SYNC(2); TSTAMP(2);
    if constexpr (DBG_STOP == 1) { dbg_probe(p, 1); return; }
    {
        PH(2) { KP_OPAQUE(p); unsigned char* ws = p->ws; unsigned char* od = (unsigned char*)p->out;
          pg8::Gemm g{(const bf16_t*)(ws + W_CQ), (const bf16_t*)(ws + W_BT2Q), MT, 768, 256}; pg8::StaticOrder S; S.init(MT, 768, G, b);
          Epi2Q E{(const float*)(ws + W_SSP), (bf16_t*)(od + O_Q)}; pg8::gemm_phase<Epi2Q, pg8::StaticOrder, GEMM_ALIGN, false>(lds, g, S, E); }
        PH(3) { KP_OPAQUE(p); unsigned char* ws = p->ws; unsigned char* od = (unsigned char*)p->out;
          pg8::Gemm g{(const bf16_t*)(ws + W_CKV), (const bf16_t*)(ws + W_BT2KV), MT, 1024, 256}; pg8::StaticOrder S; S.init(MT, 1024, G, b);
          Epi2KV E{(const float*)(ws + W_SSP), (bf16_t*)(od + O_KN), (bf16_t*)(od + O_VV)}; pg8::gemm_phase<Epi2KV, pg8::StaticOrder, GEMM_ALIGN, false>(lds, g, S, E); }
        PH(4) { KP_OPAQUE(p); fft_stage1(p, shm); }
    }
    GRID_SYNC(3); TSTAMP(3);
    if constexpr (DBG_STOP == 2) { dbg_probe(p, 2); return; }
    if constexpr (DBG_STOP == 20) { dbg_probe_qkv(p, 0); GRID_SYNC(4); dbg_probe_qkv(p, 1); return; }
    PH(5) { KP_OPAQUE(p); attn_phase(p, shm); }
    TSTAMP(13);
    PH(6) { KP_OPAQUE(p); fft_stage2(p, shm); }
    GRID_SYNC(4); TSTAMP(4);
    if constexpr (DBG_STOP == 3) { dbg_probe(p, 3); return; }
    PH(7) {
        KP_OPAQUE(p); unsigned char* ws = p->ws;
        pg8::Gemm g{(const bf16_t*)(ws + W_AF), (const bf16_t*)(ws + W_BTOUT), MT, 1024, 1024}; pg8::StaticOrder S; S.init(MT, 1024, G, b);
        EpiSS E{(bf16_t*)(ws + W_MIX), (float*)(ws + W_SS2)}; pg8::gemm_phase<EpiSS, pg8::StaticOrder, GEMM_ALIGN, GEMM_SP2>(lds, g, S, E);
    }
    GRID_SYNC(5); TSTAMP(5);
    if constexpr (DBG_STOP == 4) { dbg_probe(p, 4); return; }
    const bool p5split = (G == 256);
    PH(8) { KP_OPAQUE(p); if (p5split) phase5(p, 0, NPR + 8192, 0, G); else phase5(p, 0, MT, 0, G); }
    GRID_SYNC(6); TSTAMP(6);
    if constexpr (DBG_STOP == 5) { dbg_probe(p, 5); return; }
#pragma unroll 1
    for (int h = 0; h < 2; ++h) { const int hb = h * NPR;
        PH(9) { KP_OPAQUE(p); unsigned char* ws = p->ws; unsigned char* od = (unsigned char*)p->out; const bf16_t* XB1h = (const bf16_t*)(ws + W_XB) + (size_t)hb * DM;
          pg8::Gemm g{XB1h, (const bf16_t*)(ws + W_BTG), NPR, 2 * DFF, 1024}; pg8::OverlapOrder S; S.init2(h ? 4096 : 8192, h ? 4 : 2, 2 * DFF, G, b);
          EpiGU E{(const float*)(ws + W_R2), p->in[14], p->in[15], h ? (bf16_t*)(od + O_ACT1) : (bf16_t*)(ws + W_ACT), (PG8_LAS unsigned*)(lds + LDS_X), hb, h ? 4096 : 8192, S.nT};
          pg8::gemm_phase<EpiGU, pg8::OverlapOrder, GEMM_ALIGN, GEMM_SP2>(lds, g, S, E); }
        PH(8) { if (h == 0 && p5split) { KP_OPAQUE(p); phase5(p, NPR + 8192, MT, 172, 84); } }
        GRID_SYNC(7 + 2 * h); TSTAMP(7 + 2 * h);
        PH(11) { KP_OPAQUE(p); unsigned char* ws = p->ws; unsigned char* od = (unsigned char*)p->out;
          pg8::Gemm g{h ? (const bf16_t*)(od + O_ACT1) : (const bf16_t*)(ws + W_ACT), (const bf16_t*)(ws + W_BTD), NPR, 1024, DFF}; pg8::StaticOrder S; S.init(NPR, 1024, G, b);
          EpiSS E{(bf16_t*)(ws + W_MIX) + (size_t)hb * DM, (float*)(ws + W_SS3) + (size_t)hb * 16};     pg8::gemm_phase<EpiSS, pg8::StaticOrder, GEMM_ALIGN, GEMM_SP2>(lds, g, S, E); }
        if (h == 1) { GRID_SYNC(11); TSTAMP(11); }
    }
    if constexpr (DBG_STOP == 8) { dbg_probe(p, 8); return; }
    PH(12) { KP_OPAQUE(p); phase9(p); }
}

extern "C" void kernel_launch(void* const* d_in, const int* in_sizes, int n_in, void* d_out, int out_size, void* d_ws, size_t ws_size, hipStream_t stream) {
    static int grid_blocks = 0;
    if (grid_blocks == 0) {
        if (n_in != 18 || in_sizes[0] != NPR * DM || in_sizes[1] != NPR * DM || out_size != MT * DM || ws_size < W_END) {
            fprintf(stderr, "kernel_launch: unexpected shapes / workspace (n_in %d, ws %zu, need %zu); nothing launched\n", n_in, ws_size, (size_t)W_END); grid_blocks = -1; return; }
        int dev = 0, cus = 0, per_cu = 0;
        (void)hipGetDevice(&dev); (void)hipDeviceGetAttribute(&cus, hipDeviceAttributeMultiprocessorCount, dev);
        if (hipFuncSetAttribute((const void*)mega_fwd, hipFuncAttributeMaxDynamicSharedMemorySize, LDS_BYTES) != hipSuccess) { fprintf(stderr, "kernel_launch: hipFuncSetAttribute failed\n"); grid_blocks = -1; return; }
        if (hipOccupancyMaxActiveBlocksPerMultiprocessor(&per_cu, (const void*)mega_fwd, 512, LDS_BYTES) != hipSuccess || per_cu < 1) { fprintf(stderr, "kernel_launch: occupancy query failed (%d)\n", per_cu); grid_blocks = -1; return; }
        grid_blocks = cus * per_cu; if (grid_blocks > 256) grid_blocks = 256;
    }
    if (grid_blocks < 0) return;
    Params p{};
    for (int i = 0; i < 18; ++i) p.in[i] = (const float*)d_in[i];
    p.out = (float*)d_out; p.ws = (unsigned char*)d_ws;
    if (hipMemsetAsync((char*)d_ws + W_BAR, 0, XCD_BAR_WORDS * 4, stream) != hipSuccess) { fprintf(stderr, "kernel_launch: memset failed\n"); return; }
    void* args[] = {&p};
    hipError_t e = hipLaunchCooperativeKernel((const void*)mega_fwd, dim3(grid_blocks), dim3(512), args, LDS_BYTES, stream);
    if (e != hipSuccess) fprintf(stderr, "kernel_launch: cooperative launch failed: %s (grid %d)\n", hipGetErrorString(e), grid_blocks);
}
```

```cpp
#include <hip/hip_runtime.h>
#include <hip/hip_cooperative_groups.h>
#include <cstdio>
namespace cg = cooperative_groups;

namespace pg8 {
#define PG8_LAS __attribute__((address_space(3)))
typedef unsigned short bf16_t;
typedef short bf16x8 __attribute__((ext_vector_type(8)));
typedef float f32x4 __attribute__((ext_vector_type(4)));
typedef unsigned u32x4 __attribute__((ext_vector_type(4)));
constexpr int BM = 256, BK = 64, HALF = 128, HTB = HALF * BK * 2  , STAGE_BYTES = 8 * HTB, NXCD = 8, WGM = 8;

__host__ __device__ __forceinline__ int lds_byte(int r, int c) { const int st = (r >> 4) * 2 + (c >> 5), rr = r & 15, cc = c & 31, ob = rr * 64 + cc * 2; return st * 1024 + (ob ^ (((ob >> 9) & 1) << 5)); }
__host__ __device__ __forceinline__ void stage_rc(int b, int& R, int& C) { const int st = b / 1024, sb = b % 1024, swz = sb ^ (((sb >> 9) & 1) << 5); R = (st >> 1) * 16 + swz / 64; C = (st & 1) * 32 + (swz % 64) / 2; }
__host__ __device__ __forceinline__ int perm32(int rho) { const int n = rho >> 4, i = rho & 15; return 8 * (i >> 2) + 4 * n + (i & 3); }

struct Unit { int pm, pn; };
struct Gemm { const bf16_t* A; const bf16_t* Bt; int M, N, K; };

struct StaticOrder {
    int nM, nN, nwg, G, c;
    __host__ __device__ void init(int M, int N, int G_, int c_) { nM = M / BM; nN = N / BM; nwg = nM * nN; G = G_; c = c_; }
    __device__ __forceinline__ long long abase(const Unit& u, int K) const { return (long long)u.pm * (BM * 2) * K; }
    __host__ __device__ bool next(int i, Unit& u) const {
        const long L = (long)i * G + c; if (L >= nwg) return false;
        int wgid = (int)L; { const int q = nwg / NXCD, r = nwg % NXCD, xcd = wgid % NXCD, off = wgid / NXCD; wgid = (xcd < r ? xcd * (q + 1) : r * (q + 1) + (xcd - r) * q) + off; }
        const int nig = WGM * nN, gid = wgid / nig, fm = gid * WGM, gsz = (nM - fm) < WGM ? (nM - fm) : WGM;
        u.pm = fm + ((wgid % nig) % gsz); u.pn = (wgid % nig) / gsz; return true;
    }
    __device__ __forceinline__ void a_ready(const Unit&) const {}
    __device__ __forceinline__ void done(const Unit&) const {}
};

struct OverlapOrder : StaticOrder {
    int nT, slen;
    __host__ __device__ void init2(int slen_, int nseq, int N, int G_, int c_) { slen = slen_; nT = (slen_ + 253) / 254; nM = nseq * nT; nN = N / BM; nwg = nM * nN; G = G_; c = c_; }
    __device__ __forceinline__ int rowbase(int pm) const { const int sq = pm / nT, t = pm - sq * nT; return sq * slen + 254 * t - 1; }
    __device__ __forceinline__ long long abase(const Unit& u, int K) const { return (long long)rowbase(u.pm) * 2 * K; }
};

template <class Epi, class Sched, bool ALIGN_EPI = false, bool SP2 = false>
__device__ __forceinline__ void gemm_phase(PG8_LAS unsigned char* lds, const Gemm g, const Sched& S, const Epi& E) {
    int tid_ = threadIdx.x; asm volatile("" : "+v"(tid_));
    const int tid = tid_, wid = __builtin_amdgcn_readfirstlane(tid >> 6), lane = tid & 63, wr = wid >> 2, wc = wid & 3, fr = lane & 15, fq = lane >> 4;
    const int K = g.K, nt = K / BK;
    unsigned voffA[2], voffB[2];
#pragma unroll
    for (int i = 0; i < 2; ++i) { int R, C; stage_rc(tid * 16 + i * 8192, R, C); const int Rb = Epi::PERM ? ((R & ~31) + perm32(R & 31)) : R;
        voffA[i] = (unsigned)(R * K + C) * 2u; voffB[i] = (unsigned)(Rb * K + C) * 2u; }
    const size_t kstep = (size_t)(BK * 2);
    const size_t hstep = (size_t)HALF * K * 2;
    const size_t tstep = 2 * hstep;
    const unsigned ldsw = (unsigned)wid * 1024u;
    const int aoff = lds_byte(wr * 64 + fr, fq * 8), boff = lds_byte(wc * 32 + fr, fq * 8);
#define PG8_SA(b, h) (((b) * 2 + (h)) * HTB)
#define PG8_SB(b, h) ((4 + (b) * 2 + (h)) * HTB)
#define PG8_STAGE(bufoff, gbase, voff) do { _Pragma("unroll") for (int _i = 0; _i < 2; ++_i) \
        __builtin_amdgcn_global_load_lds((const unsigned*)((const char*)(gbase) + (voff)[_i]), (PG8_LAS unsigned*)(lds + (bufoff) + ldsw + _i * 8192), 16, 0, 0); } while (0)
#define PG8_LDA(dst, b, h) do { _Pragma("unroll") for (int m = 0; m < 4; ++m) _Pragma("unroll") for (int k = 0; k < 2; ++k) dst[m][k] = *(const PG8_LAS bf16x8*)(lds + PG8_SA(b, h) + aoff + m * 2048 + k * 1024); } while (0)
#define PG8_LDB(dst, b, h) do { _Pragma("unroll") for (int n = 0; n < 2; ++n) _Pragma("unroll") for (int k = 0; k < 2; ++k) dst[n][k] = *(const PG8_LAS bf16x8*)(lds + PG8_SB(b, h) + boff + n * 2048 + k * 1024); } while (0)
#define PG8_MMA(ai, bj, At, Bt) do { __builtin_amdgcn_s_setprio(1); _Pragma("unroll") for (int m = 0; m < 4; ++m) _Pragma("unroll") for (int n = 0; n < 2; ++n) _Pragma("unroll") for (int k = 0; k < 2; ++k) \
        acc[ai][bj][m][n] = __builtin_amdgcn_mfma_f32_16x16x32_bf16(Bt[n][k], At[m][k], acc[ai][bj][m][n], 0, 0, 0); __builtin_amdgcn_s_setprio(0); } while (0)
#define PG8_WAIT_V(n) asm volatile("s_waitcnt vmcnt(" #n ")" ::: "memory")
#define PG8_WAIT_L(n) asm volatile("s_waitcnt lgkmcnt(" #n ")" ::: "memory")
#define PG8_BAR __builtin_amdgcn_s_barrier()
#define PG8_SCHED __builtin_amdgcn_sched_barrier(0)
    Unit cur, nxt; int ui = 0;
    if (!S.next(0, cur)) return;
    f32x4 acc[2][2][4][2];
#pragma unroll
    for (int a = 0; a < 2; ++a)
#pragma unroll
        for (int b = 0; b < 2; ++b)
#pragma unroll
            for (int m = 0; m < 4; ++m)
#pragma unroll
                for (int n = 0; n < 2; ++n) acc[a][b][m][n] = (f32x4){0.f, 0.f, 0.f, 0.f};
    bf16x8 At[4][2], B0[2][2], B1[2][2];
    const char* cA = (const char*)g.A + S.abase(cur, K); const char* cB = (const char*)g.Bt + (size_t)cur.pn * tstep;
    S.a_ready(cur);
    if constexpr (SP2) {
        PG8_STAGE(PG8_SB(0, 0), cB, voffB); PG8_STAGE(PG8_SB(0, 1), cB + hstep, voffB); PG8_STAGE(PG8_SA(0, 0), cA, voffA); PG8_STAGE(PG8_SA(0, 1), cA + hstep, voffA);
        if (wr == 1) PG8_BAR;
        PG8_WAIT_V(2); PG8_BAR;
        PG8_STAGE(PG8_SB(1, 0), cB + kstep, voffB); PG8_STAGE(PG8_SA(1, 0), cA + kstep, voffA); PG8_STAGE(PG8_SB(1, 1), cB + hstep + kstep, voffB);
        PG8_WAIT_V(6); PG8_BAR;
    } else {
        PG8_STAGE(PG8_SB(0, 0), cB, voffB); PG8_STAGE(PG8_SA(0, 0), cA, voffA); PG8_STAGE(PG8_SB(0, 1), cB + hstep, voffB); PG8_STAGE(PG8_SA(0, 1), cA + hstep, voffA);
        if (wr == 1) PG8_BAR;
        PG8_WAIT_V(4); PG8_BAR;
        PG8_STAGE(PG8_SB(1, 0), cB + kstep, voffB); PG8_STAGE(PG8_SA(1, 0), cA + kstep, voffA); PG8_STAGE(PG8_SB(1, 1), cB + hstep + kstep, voffB);
        PG8_WAIT_V(6); PG8_BAR;
    }
    for (;;) {
        const bool has_next = S.next(ui + 1, nxt);
        const char* nA = has_next ? (const char*)g.A + S.abase(nxt, K) : cA; const char* nB = has_next ? (const char*)g.Bt + (size_t)nxt.pn * tstep : cB;
        for (int t = 0; t < nt; t += 2) {
            const bool last = (t == nt - 2);
            const char* a1 = cA + (size_t)(t + 1) * kstep;
            const char* a2 = last ? nA : cA + (size_t)(t + 2) * kstep; const char* b2 = last ? nB : cB + (size_t)(t + 2) * kstep;
            const char* a3 = a2 + kstep; const char* b3 = b2 + kstep;
            if (last && has_next) S.a_ready(nxt);
            if constexpr (SP2) {
            PG8_LDB(B0, 0, 0); PG8_LDB(B1, 0, 1); PG8_SCHED; PG8_LDA(At, 0, 0); PG8_STAGE(PG8_SA(1, 1), a1 + hstep, voffA);
            PG8_WAIT_V(8); PG8_WAIT_L(0); PG8_BAR; PG8_MMA(0, 0, At, B0); PG8_MMA(0, 1, At, B1); PG8_BAR; PG8_SCHED;
            PG8_LDA(At, 0, 1); PG8_STAGE(PG8_SB(0, 0), b2, voffB); PG8_STAGE(PG8_SB(0, 1), b2 + hstep, voffB); PG8_STAGE(PG8_SA(0, 0), a2, voffA);
            PG8_WAIT_V(8); PG8_WAIT_L(0); PG8_BAR; PG8_MMA(1, 0, At, B0); PG8_MMA(1, 1, At, B1); PG8_BAR; PG8_SCHED;
            PG8_LDB(B0, 1, 0); PG8_LDB(B1, 1, 1); PG8_SCHED; PG8_LDA(At, 1, 0); PG8_STAGE(PG8_SA(0, 1), a2 + hstep, voffA);
            PG8_WAIT_V(8); PG8_WAIT_L(0); PG8_BAR; PG8_MMA(0, 0, At, B0); PG8_MMA(0, 1, At, B1); PG8_BAR; PG8_SCHED;
            PG8_LDA(At, 1, 1); PG8_STAGE(PG8_SB(1, 0), b3, voffB); PG8_STAGE(PG8_SB(1, 1), b3 + hstep, voffB); PG8_STAGE(PG8_SA(1, 0), a3, voffA);
            PG8_WAIT_V(8); PG8_WAIT_L(0); PG8_BAR; PG8_MMA(1, 0, At, B0); PG8_MMA(1, 1, At, B1); PG8_BAR; PG8_SCHED;
            } else {
            PG8_LDB(B0, 0, 0); PG8_SCHED; PG8_LDA(At, 0, 0); PG8_STAGE(PG8_SA(1, 1), a1 + hstep, voffA);
            PG8_WAIT_L(8); PG8_BAR; PG8_WAIT_L(0); PG8_MMA(0, 0, At, B0); PG8_BAR; PG8_SCHED;
            PG8_LDB(B1, 0, 1); PG8_STAGE(PG8_SB(0, 0), b2, voffB);
            PG8_BAR; PG8_WAIT_L(0); PG8_MMA(0, 1, At, B1); PG8_BAR;
            PG8_LDA(At, 0, 1); PG8_STAGE(PG8_SA(0, 0), a2, voffA);
            PG8_BAR; PG8_WAIT_L(0); PG8_MMA(1, 0, At, B0); PG8_BAR; PG8_SCHED;
            PG8_STAGE(PG8_SB(0, 1), b2 + hstep, voffB);
            PG8_WAIT_V(6); PG8_BAR; PG8_MMA(1, 1, At, B1); PG8_BAR;
            PG8_LDB(B0, 1, 0); PG8_SCHED; PG8_LDA(At, 1, 0); PG8_STAGE(PG8_SA(0, 1), a2 + hstep, voffA);
            PG8_WAIT_L(8); PG8_BAR; PG8_WAIT_L(0); PG8_MMA(0, 0, At, B0); PG8_BAR; PG8_SCHED;
            PG8_LDB(B1, 1, 1); PG8_STAGE(PG8_SB(1, 0), b3, voffB);
            PG8_BAR; PG8_WAIT_L(0); PG8_MMA(0, 1, At, B1); PG8_BAR;
            PG8_LDA(At, 1, 1); PG8_STAGE(PG8_SA(1, 0), a3, voffA);
            PG8_BAR; PG8_WAIT_L(0); PG8_MMA(1, 0, At, B0); PG8_BAR; PG8_SCHED;
            PG8_STAGE(PG8_SB(1, 1), b3 + hstep, voffB);
            PG8_WAIT_V(6); PG8_BAR; PG8_MMA(1, 1, At, B1); PG8_BAR;
            }
        }
        if constexpr (ALIGN_EPI) { if (wr == 0) PG8_BAR; }
        if constexpr (!Epi::AFTER_DRAIN) { E(acc, cur, wr, wc, fr, fq); S.done(cur); }
        if (!has_next) break;
#pragma unroll
        for (int a = 0; a < 2; ++a)
#pragma unroll
            for (int b = 0; b < 2; ++b)
#pragma unroll
                for (int m = 0; m < 4; ++m)
#pragma unroll
                    for (int n = 0; n < 2; ++n) acc[a][b][m][n] = (f32x4){0.f, 0.f, 0.f, 0.f};
        cur = nxt; cA = nA; cB = nB; ++ui;
        if constexpr (ALIGN_EPI) { if (wr == 1) PG8_BAR; }
    }
    PG8_WAIT_V(0);
    if constexpr (!ALIGN_EPI) { if (wr == 0) PG8_BAR; }
    PG8_BAR;
    if constexpr (Epi::AFTER_DRAIN) { E.fused(acc, cur, wr, wc, fr, fq, lds, wid, lane); S.done(cur); }
#undef PG8_SA
#undef PG8_SB
#undef PG8_STAGE
#undef PG8_LDA
#undef PG8_LDB
#undef PG8_MMA
#undef PG8_WAIT_V
#undef PG8_WAIT_L
#undef PG8_BAR
#undef PG8_SCHED
}

}

using pg8::bf16_t; using pg8::bf16x8; using pg8::f32x4; using pg8::u32x4; using pg8::Unit;
typedef float f32x16 __attribute__((ext_vector_type(16)));
typedef short s16x4 __attribute__((ext_vector_type(4)));
typedef unsigned u32x2 __attribute__((ext_vector_type(2)));

constexpr int MT = 32768, NPR = 16384, DM = 1024, DFF = 2816, NIN = 1056;
constexpr float EPS = 1e-6f;
constexpr float QSCALE = 0.10206207261596575f * 1.4426950408889634f;
constexpr size_t MiB = 1048576;
constexpr size_t W_BT1 = 0, W_BT2Q = W_BT1 + 1792 * 1024 * 2, W_BT2KV = W_BT2Q + 768 * 256 * 2, W_BTOUT = W_BT2KV + 1024 * 256 * 2, W_BTG = W_BTOUT + 1024 * 1024 * 2,
                 W_BTU = W_BTG + (size_t)DFF * 1024 * 2, W_BTD = W_BTU + (size_t)DFF * 1024 * 2, W_F1 = W_BTD + (size_t)DFF * 1024 * 2, W_F2A = W_F1 + 128 * 128 * 2, W_F2B = W_F2A + 128 * 256 * 2,
                 W_RCOS = W_F2B + 64 * 128 * 2, W_RSIN = W_RCOS + 8192 * 16 * 4, W_TW = W_RSIN + 8192 * 16 * 4, W_RX = W_TW + 8192 * 8, W_R2 = W_RX + MT * 4, W_SSP = W_R2 + MT * 4,
                 W_SS2 = W_SSP + (size_t)MT * 8 * 4, W_SS3 = W_SS2 + (size_t)MT * 16 * 4, W_KRP = W_SS3 + (size_t)MT * 16 * 4, W_BAR = W_KRP + (size_t)MT * 32 * 2, W_TS = W_BAR + 16384, W_SMALL_END = W_TS + 256;
static_assert(W_SMALL_END <= 32 * MiB, "small region");
constexpr size_t W_XB = 32 * MiB  , W_MIX = 96 * MiB  , W_CQ = W_MIX, W_CKV = W_MIX + 16 * MiB, W_ACT = 160 * MiB  , W_VC = W_ACT, W_AF = W_ACT,
                 W_END = 248 * MiB;
constexpr size_t O_Q = 0, O_KN = 48 * MiB, O_VV = 80 * MiB, O_ACT1 = 0;
#ifndef GEMM_ALIGN
#define GEMM_ALIGN true
#endif
#ifndef GEMM_SP2
#define GEMM_SP2 true
#endif
constexpr int LDS_X = 131072 + 64, LDS_BYTES = LDS_X + 2048;

#ifndef DIAG_A
#define DIAG_A -1
#define DIAG_B 0
#define DIAG_C 0
#define DIAG_D 0
#endif
struct Params { const float* in[18]; float* out; unsigned char* ws; };
typedef const __attribute__((address_space(4))) Params* KP;
#define KP_OPAQUE(p) asm volatile("" : "+s"(p))

typedef __bf16 bf16x2_t __attribute__((ext_vector_type(2)));
typedef float f32x2_t __attribute__((ext_vector_type(2)));
__device__ __forceinline__ unsigned cvtpk(float lo, float hi) { f32x2_t v = {lo, hi}; bf16x2_t b = __builtin_convertvector(v, bf16x2_t); return __builtin_bit_cast(unsigned, b); }
__device__ __forceinline__ bf16_t f2bf(float f) { return (bf16_t)(cvtpk(f, 0.f) & 0xffffu); }
__device__ __forceinline__ u32x4 pack8(f32x4 a, f32x4 b) { u32x4 w; w.x = cvtpk(a[0], a[1]); w.y = cvtpk(a[2], a[3]); w.z = cvtpk(b[0], b[1]); w.w = cvtpk(b[2], b[3]); return w; }
__device__ __forceinline__ float bflo(unsigned u) { return __uint_as_float(u << 16); }
__device__ __forceinline__ float bfhi(unsigned u) { return __uint_as_float(u & 0xffff0000u); }
__device__ __forceinline__ void unpack8(u32x4 w, f32x4& a, f32x4& b) { a = (f32x4){bflo(w.x), bfhi(w.x), bflo(w.y), bfhi(w.y)}; b = (f32x4){bflo(w.z), bfhi(w.z), bflo(w.w), bfhi(w.w)}; }
__device__ __forceinline__ int tok_pos(int row) { return row < NPR ? (row & 8191) : (row & 4095); }
__device__ __forceinline__ int tok_len(int row) { return row < NPR ? 8192 : 4096; }
__device__ __forceinline__ float wave_sum(float v) { for (int o = 32; o >= 1; o >>= 1) v += __shfl_xor(v, o); return v; }

#define EPI_ARGS const f32x4 (&acc)[2][2][4][2], const Unit& u, int wr, int wc, int fr_, int fq_
#define EPI_LOCALS int t_ = threadIdx.x; asm volatile("" : "+v"(t_)); const int fr = t_ & 15, fq = (t_ >> 4) & 3;
struct Epi1 {
    static constexpr bool PERM = true, AFTER_DRAIN = false;
    const float* RX; bf16_t* CQ; bf16_t* CKV; float* SSP; bf16_t* VC; bf16_t* KRP; const float* RCOS; const float* RSIN;
    __device__ __forceinline__ void operator()(EPI_ARGS) const {
        EPI_LOCALS
        const int row0 = u.pm * 256 + wr * 64 + fr, colt = wc * 32 + 8 * fq; float rxv[2][4];
#pragma unroll
        for (int ai = 0; ai < 2; ++ai)
#pragma unroll
            for (int m = 0; m < 4; ++m) rxv[ai][m] = RX[row0 + ai * 128 + m * 16];
        if (u.pn < 2) {
            bf16_t* dst = u.pn == 0 ? CQ : CKV;
#pragma unroll
            for (int ai = 0; ai < 2; ++ai)
#pragma unroll
                for (int m = 0; m < 4; ++m) { const int row = row0 + ai * 128 + m * 16; const float rx = rxv[ai][m]; float ss = 0.f;
#pragma unroll
                    for (int bj = 0; bj < 2; ++bj) { const f32x4 v0 = acc[ai][bj][m][0] * rx, v1 = acc[ai][bj][m][1] * rx;
                        ss += (v0[0] * v0[0] + v0[1] * v0[1]) + (v0[2] * v0[2] + v0[3] * v0[3]) + (v1[0] * v1[0] + v1[1] * v1[1]) + (v1[2] * v1[2] + v1[3] * v1[3]);
                        *(u32x4*)(dst + (unsigned)(row * 256 + bj * 128 + colt)) = pack8(v0, v1); }
                    ss += __shfl_xor(ss, 16); ss += __shfl_xor(ss, 32);
                    if (fq == 0) SSP[(unsigned)(row * 8 + u.pn * 4 + wc)] = ss; }
        } else if (u.pn < 6) {
#pragma unroll
            for (int ai = 0; ai < 2; ++ai)
#pragma unroll
                for (int m = 0; m < 4; ++m) { const int row = row0 + ai * 128 + m * 16; const float rx = rxv[ai][m];
#pragma unroll
                    for (int bj = 0; bj < 2; ++bj) *(u32x4*)(VC + (unsigned)(row * 1024 + (u.pn - 2) * 256 + bj * 128 + colt)) = pack8(acc[ai][bj][m][0] * rx, acc[ai][bj][m][1] * rx); }
        } else if (wc == 0) {
#pragma unroll
            for (int ai = 0; ai < 2; ++ai)
#pragma unroll
                for (int m = 0; m < 4; ++m) { const int row = row0 + ai * 128 + m * 16; const float rx = rxv[ai][m]; const int pos = tok_pos(row);
                    const f32x4 c4 = *(const f32x4*)(RCOS + pos * 16 + 4 * fq), s4 = *(const f32x4*)(RSIN + pos * 16 + 4 * fq);
                    const f32x4 x1 = acc[ai][0][m][0] * rx, x2 = acc[ai][0][m][1] * rx;
                    *(u32x4*)(KRP + (unsigned)(row * 32 + 8 * fq)) = pack8(x1 * c4 - x2 * s4, x2 * c4 + x1 * s4); }
        }
    }
};
struct Epi2Q {
    static constexpr bool PERM = true, AFTER_DRAIN = false;
    const float* SSP; bf16_t* Q;
    __device__ __forceinline__ void operator()(EPI_ARGS) const {
        EPI_LOCALS
        const int row0 = u.pm * 256 + wr * 64 + fr;
        const int G0 = 32 * u.pn + 4 * wc + fq, h0 = G0 / 12, p0 = G0 - 12 * h0, G1 = G0 + 16, h1 = G1 / 12, p1 = G1 - 12 * h1;
        const unsigned base0 = (unsigned)(h0 * MT * 96 + 8 * p0), base1 = (unsigned)(h1 * MT * 96 + 8 * p1);
#pragma unroll
        for (int ai = 0; ai < 2; ++ai) { float rq[4];
#pragma unroll
            for (int m = 0; m < 4; ++m) { const f32x4 sp = *(const f32x4*)(SSP + (unsigned)((row0 + ai * 128 + m * 16) * 8)); rq[m] = rsqrtf(((sp[0] + sp[1]) + (sp[2] + sp[3])) * (1.0f / 256.0f) + EPS); }
#pragma unroll
            for (int m = 0; m < 4; ++m) { const unsigned ro = (unsigned)((row0 + ai * 128 + m * 16) * 96);
                *(u32x4*)(Q + base0 + ro) = pack8(acc[ai][0][m][0] * rq[m], acc[ai][0][m][1] * rq[m]);
                *(u32x4*)(Q + base1 + ro) = pack8(acc[ai][1][m][0] * rq[m], acc[ai][1][m][1] * rq[m]); }
            asm volatile("" ::: "memory"); }
    }
};
struct Epi2KV {
    static constexpr bool PERM = true, AFTER_DRAIN = false;
    const float* SSP; bf16_t* KN; bf16_t* VV;
    __device__ __forceinline__ void operator()(EPI_ARGS) const {
        EPI_LOCALS
        const int row0 = u.pm * 256 + wr * 64 + fr; const int within = (wc & 1) * 32 + 8 * fq; bf16_t* dst = wc < 2 ? KN : VV; float rk[2][4];
#pragma unroll
        for (int ai = 0; ai < 2; ++ai)
#pragma unroll
            for (int m = 0; m < 4; ++m) { const f32x4 sp = *(const f32x4*)(SSP + (unsigned)((row0 + ai * 128 + m * 16) * 8 + 4)); rk[ai][m] = rsqrtf(((sp[0] + sp[1]) + (sp[2] + sp[3])) * (1.0f / 256.0f) + EPS); }
#pragma unroll
        for (int ai = 0; ai < 2; ++ai)
#pragma unroll
            for (int m = 0; m < 4; ++m) { const int row = row0 + ai * 128 + m * 16;
#pragma unroll
                for (int bj = 0; bj < 2; ++bj) { const int head = 2 * u.pn + bj;
                    *(u32x4*)(dst + (unsigned)((head * MT + row) * 64 + within)) = pack8(acc[ai][bj][m][0] * rk[ai][m], acc[ai][bj][m][1] * rk[ai][m]); } }
    }
};
struct EpiSS {
    static constexpr bool PERM = true, AFTER_DRAIN = false;
    bf16_t* O; float* SS;
    __device__ __forceinline__ void operator()(EPI_ARGS) const {
        EPI_LOCALS
        const int row0 = u.pm * 256 + wr * 64 + fr, colt = u.pn * 256 + wc * 32 + 8 * fq;
#pragma unroll
        for (int ai = 0; ai < 2; ++ai)
#pragma unroll
            for (int m = 0; m < 4; ++m) { const int row = row0 + ai * 128 + m * 16; float ss = 0.f;
#pragma unroll
                for (int bj = 0; bj < 2; ++bj) { const f32x4 v0 = acc[ai][bj][m][0], v1 = acc[ai][bj][m][1];
                    ss += (v0[0] * v0[0] + v0[1] * v0[1]) + (v0[2] * v0[2] + v0[3] * v0[3]) + (v1[0] * v1[0] + v1[1] * v1[1]) + (v1[2] * v1[2] + v1[3] * v1[3]);
                    *(u32x4*)(O + (unsigned)(row * 1024 + bj * 128 + colt)) = pack8(v0, v1); }
                ss += __shfl_xor(ss, 16); ss += __shfl_xor(ss, 32);
                if (fq == 0) SS[(unsigned)(row * 16 + u.pn * 4 + wc)] = ss; }
    }
};
struct EpiGate {
    static constexpr bool PERM = true, AFTER_DRAIN = false;
    const float* R2; bf16_t* G;
    __device__ __forceinline__ void operator()(EPI_ARGS) const {
        EPI_LOCALS
        const int row0 = u.pm * 256 + wr * 64 + fr, colt = u.pn * 256 + wc * 32 + 8 * fq;
#pragma unroll
        for (int ai = 0; ai < 2; ++ai)
#pragma unroll
            for (int m = 0; m < 4; ++m) { const int row = row0 + ai * 128 + m * 16; const float r2 = R2[row];
#pragma unroll
                for (int bj = 0; bj < 2; ++bj) *(u32x4*)(G + (unsigned)(row * DFF + bj * 128 + colt)) = pack8(acc[ai][bj][m][0] * r2, acc[ai][bj][m][1] * r2); }
    }
};
__device__ __forceinline__ float gelu_t(float x) {
    const float u2 = x * (1.5957691216057308f + 0.07135481627159855f * x * x);
    return x * __builtin_amdgcn_rcpf(1.0f + __builtin_amdgcn_exp2f(-1.4426950408889634f * u2));
}
__device__ __forceinline__ f32x4 gelu_mul4(f32x4 x, f32x4 y) {
    const f32x4 t = x * (x * x * (-0.10294324283f) + (-2.3022081910f));
    f32x4 e; e[0] = __builtin_amdgcn_exp2f(t[0]); e[1] = __builtin_amdgcn_exp2f(t[1]); e[2] = __builtin_amdgcn_exp2f(t[2]); e[3] = __builtin_amdgcn_exp2f(t[3]);
    const f32x4 d = e + 1.0f; f32x4 r; r[0] = __builtin_amdgcn_rcpf(d[0]); r[1] = __builtin_amdgcn_rcpf(d[1]); r[2] = __builtin_amdgcn_rcpf(d[2]); r[3] = __builtin_amdgcn_rcpf(d[3]);
    return (x * y) * r;
}
template <int CTRL> __device__ __forceinline__ u32x4 dppv(u32x4 old, u32x4 src) {
    u32x4 r; r.x = (unsigned)__builtin_amdgcn_update_dpp((int)old.x, (int)src.x, CTRL, 0xf, 0xf, false); r.y = (unsigned)__builtin_amdgcn_update_dpp((int)old.y, (int)src.y, CTRL, 0xf, 0xf, false);
    r.z = (unsigned)__builtin_amdgcn_update_dpp((int)old.z, (int)src.z, CTRL, 0xf, 0xf, false); r.w = (unsigned)__builtin_amdgcn_update_dpp((int)old.w, (int)src.w, CTRL, 0xf, 0xf, false); return r; }
struct EpiUp {
    static constexpr bool PERM = true, AFTER_DRAIN = false;
    const float* R2; const bf16_t* G; const float* CW; const float* CB; bf16_t* ACT; int hb;
    __device__ __forceinline__ void operator()(EPI_ARGS) const {
        EPI_LOCALS
        const int row0 = u.pm * 256 + wr * 64 + fr;
#pragma unroll
        for (int bj = 0; bj < 2; ++bj) { const int col = u.pn * 256 + bj * 128 + wc * 32 + 8 * fq;
            const f32x4 w0a = *(const f32x4*)(CW + col), w0b = *(const f32x4*)(CW + col + 4), w1a = *(const f32x4*)(CW + DFF + col), w1b = *(const f32x4*)(CW + DFF + col + 4),
                        w2a = *(const f32x4*)(CW + 2 * DFF + col), w2b = *(const f32x4*)(CW + 2 * DFF + col + 4), ba = *(const f32x4*)(CB + col), bb = *(const f32x4*)(CB + col + 4);
#pragma unroll
            for (int ai = 0; ai < 2; ++ai) { const int rA = row0 + ai * 128, rZ = rA + 48; const bf16_t* gp = G + (unsigned)(rA * DFF + col);
                u32x4 cen[4], pb = {0u, 0u, 0u, 0u}, nb = {0u, 0u, 0u, 0u}; float r2v[4];
#pragma unroll
                for (int m = 0; m < 4; ++m) { cen[m] = *(const u32x4*)(gp + m * 16 * DFF); r2v[m] = R2[rA + m * 16]; }
                if (fr == 0 && tok_pos(hb + rA) > 0) pb = *(const u32x4*)(gp - DFF);
                if (fr == 15 && tok_pos(hb + rZ) < tok_len(hb + rZ) - 1) nb = *(const u32x4*)(gp + 49 * DFF);
#pragma unroll
                for (int m = 0; m < 4; ++m) { const int row = rA + m * 16;
                    const u32x4 tp = (m == 0) ? pb : dppv<0x121>(cen[m == 0 ? 0 : m - 1], cen[m == 0 ? 0 : m - 1]);
                    const u32x4 tn = (m == 3) ? nb : dppv<0x12F>(cen[m == 3 ? 3 : m + 1], cen[m == 3 ? 3 : m + 1]);
                    const u32x4 w0 = dppv<0x111>(tp, cen[m]), w2 = dppv<0x101>(tn, cen[m]);
                    f32x4 g0a, g0b, g1a, g1b, g2a, g2b; unpack8(w0, g0a, g0b); unpack8(cen[m], g1a, g1b); unpack8(w2, g2a, g2b);
                    const f32x4 ta = ba + w0a * g0a + w1a * g1a + w2a * g2a, tb = bb + w0b * g0b + w1b * g1b + w2b * g2b;
                    const f32x4 ua = acc[ai][bj][m][0] * r2v[m], ub = acc[ai][bj][m][1] * r2v[m];
                    f32x4 oa, ob;
#pragma unroll
                    for (int j = 0; j < 4; ++j) { oa[j] = gelu_t(ta[j]) * ua[j]; ob[j] = gelu_t(tb[j]) * ub[j]; }
                    *(u32x4*)(ACT + (unsigned)(row * DFF + col)) = pack8(oa, ob); }
                asm volatile("" ::: "memory"); } }
    }
};

struct EpiGU {
    static constexpr bool PERM = true, AFTER_DRAIN = false;
    const float* R2; const float* CW; const float* CB; bf16_t* ACT; PG8_LAS unsigned* X; int hb, slen, nT;
    __device__ __forceinline__ void operator()(EPI_ARGS) const {
        EPI_LOCALS
        const int sq = u.pm / nT, tt = u.pm - sq * nT, rb = sq * slen + 254 * tt - 1;
        const int col = u.pn * 128 + wc * 32 + 8 * fq, li0 = wr * 64 + fr;
        float r2v[2][4];
#pragma unroll
        for (int ai = 0; ai < 2; ++ai)
#pragma unroll
            for (int m = 0; m < 4; ++m) { int gr = hb + rb + ai * 128 + li0 + m * 16; gr = gr < 0 ? 0 : (gr > MT - 1 ? MT - 1 : gr); r2v[ai][m] = R2[gr]; }
        const f32x4 w0a = *(const f32x4*)(CW + col), w0b = *(const f32x4*)(CW + col + 4), w1a = *(const f32x4*)(CW + DFF + col), w1b = *(const f32x4*)(CW + DFF + col + 4),
                    w2a = *(const f32x4*)(CW + 2 * DFF + col), w2b = *(const f32x4*)(CW + 2 * DFF + col + 4), ba = *(const f32x4*)(CB + col), bb = *(const f32x4*)(CB + col + 4);
#pragma unroll
        for (int ai = 0; ai < 2; ++ai) { PG8_LAS unsigned* xs = X + (((wr * 4 + wc) * 2 + ai) * 2) * 16 + fq * 4;
            if (fr == 0) *(PG8_LAS u32x4*)xs = pack8(acc[ai][0][0][0] * r2v[ai][0], acc[ai][0][0][1] * r2v[ai][0]);
            if (fr == 15) *(PG8_LAS u32x4*)(xs + 16) = pack8(acc[ai][0][3][0] * r2v[ai][3], acc[ai][0][3][1] * r2v[ai][3]); }
        asm volatile("s_waitcnt lgkmcnt(0)" ::: "memory"); __builtin_amdgcn_s_barrier(); if (!GEMM_ALIGN && wr == 0) __builtin_amdgcn_s_barrier(); asm volatile("" ::: "memory");
        const int pw = wr ^ 1;
#pragma unroll
        for (int ai = 0; ai < 2; ++ai) {
            const int pai = wr ? ai : ai - 1, nai = wr ? ai + 1 : ai;
            u32x4 pb = {0u, 0u, 0u, 0u}, nb = {0u, 0u, 0u, 0u};
            if (pai >= 0) pb = *(const PG8_LAS u32x4*)(X + (((pw * 4 + wc) * 2 + pai) * 2 + 1) * 16 + fq * 4);
            if (nai <= 1) nb = *(const PG8_LAS u32x4*)(X + (((pw * 4 + wc) * 2 + nai) * 2 + 0) * 16 + fq * 4);
            u32x4 cen[4];
#pragma unroll
            for (int m = 0; m < 4; ++m) cen[m] = pack8(acc[ai][0][m][0] * r2v[ai][m], acc[ai][0][m][1] * r2v[ai][m]);
#pragma unroll
            for (int m = 0; m < 4; ++m) { const int li = ai * 128 + li0 + m * 16, row = rb + li, pos = row - sq * slen;
                const u32x4 tp = (m == 0) ? pb : dppv<0x121>(cen[m == 0 ? 0 : m - 1], cen[m == 0 ? 0 : m - 1]);
                const u32x4 tn = (m == 3) ? nb : dppv<0x12F>(cen[m == 3 ? 3 : m + 1], cen[m == 3 ? 3 : m + 1]);
                u32x4 w0 = dppv<0x111>(tp, cen[m]), w2 = dppv<0x101>(tn, cen[m]);
                if (pos == 0) w0 = (u32x4){0u, 0u, 0u, 0u};
                if (pos == slen - 1) w2 = (u32x4){0u, 0u, 0u, 0u};
                f32x4 g0a, g0b, g1a, g1b, g2a, g2b; unpack8(w0, g0a, g0b); unpack8(cen[m], g1a, g1b); unpack8(w2, g2a, g2b);
                const f32x4 ta = ba + w0a * g0a + w1a * g1a + w2a * g2a, tb = bb + w0b * g0b + w1b * g1b + w2b * g2b;
                const f32x4 ua = acc[ai][1][m][0] * r2v[ai][m], ub = acc[ai][1][m][1] * r2v[ai][m];
                const f32x4 oa = gelu_mul4(ta, ua), ob = gelu_mul4(tb, ub);
                if (li >= 1 && li <= 254 && pos >= 0 && pos < slen) *(u32x4*)(ACT + (unsigned)(row * DFF + col)) = pack8(oa, ob); }
            asm volatile("" ::: "memory"); }
        if (!GEMM_ALIGN && wr == 1) { asm volatile("s_waitcnt lgkmcnt(0)" ::: "memory"); __builtin_amdgcn_s_barrier(); }
    }
};

template <class F> __device__ __forceinline__ void ttile(const F& src, bf16_t* dst, int lddst, int k0, int n0, float* tile) {
    const int tid = threadIdx.x, a = tid >> 6, b = tid & 63;
#pragma unroll
    for (int i = 0; i < 8; ++i) { const int kk = a + 8 * i; tile[kk * 65 + b] = src(k0 + kk, n0 + b); }
    __syncthreads();
    const int a2 = tid >> 5, b2 = (tid & 31) * 2;
#pragma unroll
    for (int i = 0; i < 4; ++i) { const int nn = a2 + 16 * i; *(unsigned*)(dst + (size_t)(n0 + nn) * lddst + k0 + b2) = cvtpk(tile[b2 * 65 + nn], tile[(b2 + 1) * 65 + nn]); }
    __syncthreads();
}
__device__ __forceinline__ void ttile128(const float* w, int ld, const float* g, bf16_t* dst, int lddst, int k0, int n0, int dstrow0, float* tile, int tid) {
#pragma unroll
    for (int i = 0; i < 8; ++i) { const int idx = tid + 512 * i, kk = idx >> 5, n4 = (idx & 31) * 4;
        f32x4 v = *(const f32x4*)(w + (size_t)(k0 + kk) * ld + n0 + n4); if (g) v = v * g[k0 + kk];
        float* t = tile + kk * 129 + n4; t[0] = v[0]; t[1] = v[1]; t[2] = v[2]; t[3] = v[3]; }
    __syncthreads();
#pragma unroll
    for (int i = 0; i < 4; ++i) { const int idx = tid + 512 * i, nn = idx >> 4, k8 = (idx & 15) * 8; const float* t = tile + k8 * 129 + nn;
        u32x4 o; o.x = cvtpk(t[0], t[129]); o.y = cvtpk(t[2 * 129], t[3 * 129]); o.z = cvtpk(t[4 * 129], t[5 * 129]); o.w = cvtpk(t[6 * 129], t[7 * 129]);
        *(u32x4*)(dst + (size_t)(dstrow0 + nn) * lddst + k0 + k8) = o; }
    __syncthreads();
}
struct SrcPlain { const float* w; int ld; const float* g; float mul; __device__ __forceinline__ float operator()(int k, int n) const { return w[(size_t)k * ld + n] * (g ? g[k] : 1.0f) * mul; } };
struct SrcQ { const float* w; const float* g; __device__ __forceinline__ float operator()(int k, int n) const {
    const int G = n >> 3, i8 = n & 7, head = G / 12, part = G - 12 * head; int oc;
    if (part < 8) oc = head * 96 + 8 * part + i8; else { const int i = part - 8; oc = head * 96 + 64 + (i8 < 4 ? 4 * i + i8 : 16 + 4 * i + (i8 - 4)); }
    return w[(size_t)k * 768 + oc] * g[k] * QSCALE; } };
struct SrcKR { const float* w; const float* g; __device__ __forceinline__ float operator()(int k, int p) const {
    if (p >= 32) return 0.f; const int oc = 512 + ((p >> 2) & 1) * 16 + 4 * (p >> 3) + (p & 3); return w[(size_t)k * NIN + oc] * g[k]; } };
struct SrcV { const float* w; const float* g; const float* cs; __device__ __forceinline__ float operator()(int k, int n) const {
    const int chp = n >> 1, reim = n & 1, grp = chp >> 7, cp = chp & 127; const float* wr = w + (size_t)k * NIN + 544 + grp * 128; float s = 0.f;
    for (int c = 0; c < 128; ++c) s += wr[c] * cs[2 * ((c * cp) & 127) + reim];
    return s * g[k] * 0.08838834764831845f; } };
struct SrcFO { const float* wf; const float* wo; __device__ __forceinline__ float operator()(int k, int n) const {
    const int kk = k - 512, grp = kk >> 7; const float* a = wf + (size_t)kk * 128; const float* b = wo + (size_t)(512 + grp * 128) * 1024 + n; float s = 0.f;
    for (int c2 = 0; c2 < 128; ++c2) s += a[c2] * b[(size_t)c2 * 1024];
    return s; } };

template <int UF, class FA, class FB> __device__ __forceinline__ void tile_mm(const FA& fa, const FB& fb, bf16_t* dst, int lddst, int k0, int n0, float* tile, float* As, float* Bs, int tid) {
    const int a = tid >> 6, b = tid & 63;
#pragma unroll UF
    for (int i = 0; i < 16; ++i) { const int idx = tid + 512 * i; As[(idx >> 7) * 132 + (idx & 127)] = fa(idx >> 7, idx & 127); }
#pragma unroll UF
    for (int i = 0; i < 16; ++i) { const int idx = tid + 512 * i; Bs[idx] = fb(idx >> 6, idx & 63); }
    __syncthreads();
    float acc[8] = {0.f, 0.f, 0.f, 0.f, 0.f, 0.f, 0.f, 0.f};
    for (int c = 0; c < 128; c += 4) { const float b0 = Bs[c * 64 + b], b1 = Bs[(c + 1) * 64 + b], b2 = Bs[(c + 2) * 64 + b], b3 = Bs[(c + 3) * 64 + b];
#pragma unroll
        for (int i = 0; i < 8; ++i) { const f32x4 av = *(const f32x4*)(As + (a + 8 * i) * 132 + c); acc[i] += (av[0] * b0 + av[1] * b1) + (av[2] * b2 + av[3] * b3); } }
#pragma unroll
    for (int i = 0; i < 8; ++i) tile[(a + 8 * i) * 65 + b] = acc[i];
    __syncthreads();
    const int a2 = tid >> 5, b2_ = (tid & 31) * 2;
#pragma unroll
    for (int i = 0; i < 4; ++i) { const int nn = a2 + 16 * i; *(unsigned*)(dst + (size_t)(n0 + nn) * lddst + k0 + b2_) = cvtpk(tile[b2_ * 65 + nn], tile[(b2_ + 1) * 65 + nn]); }
    __syncthreads();
}
struct MmVA { const float* w; const float* g; int k0, grp; __device__ __forceinline__ float operator()(int kk, int c) const { return w[(size_t)(k0 + kk) * NIN + 544 + grp * 128 + c] * g[k0 + kk] * 0.08838834764831845f; } };
struct MmVB { const float* cs; int n0; __device__ __forceinline__ float operator()(int c, int nn) const { const int n = n0 + nn, cp = (n >> 1) & 127; return cs[2 * ((c * cp) & 127) + (n & 1)]; } };
struct MmFA { const float* wf; int kb; __device__ __forceinline__ float operator()(int kk, int c2) const { return wf[(size_t)(kb + kk) * 128 + c2]; } };
struct MmFB { const float* wo; int grp, n0; __device__ __forceinline__ float operator()(int c2, int nn) const { return wo[(size_t)(512 + grp * 128 + c2) * 1024 + n0 + nn]; } };

__device__ __forceinline__ void phase0(KP p, unsigned char* shm) {
    int tid_ = threadIdx.x; asm volatile("" : "+v"(tid_));
    const int tid = tid_, lane = tid & 63, wid = tid >> 6, G = gridDim.x, b = blockIdx.x;
    unsigned char* ws = p->ws;
    float* tile = (float*)shm; float* cs = (float*)(shm + 102400); float* As = (float*)(shm + 32768); float* Bs = (float*)(shm + 32768 + 64 * 132 * 4);
    if (tid < 128) { float s, c; sincospif((float)tid * (1.0f / 64.0f), &s, &c); cs[2 * tid] = c; cs[2 * tid + 1] = -s; }
    __syncthreads();
    const float *x_in = p->in[2]  , *w_in = p->in[3], *g_q = p->in[4], *w_uq = p->in[5], *g_kv = p->in[6], *w_ukv = p->in[7], *w_fnet = p->in[8], *w_out = p->in[9],
                *g_pre_ffn = p->in[11], *w_gate = p->in[12], *w_up = p->in[13], *w_down = p->in[16];
    bf16_t *BT1 = (bf16_t*)(ws + W_BT1), *BT2Q = (bf16_t*)(ws + W_BT2Q), *BT2KV = (bf16_t*)(ws + W_BT2KV), *BTOUT = (bf16_t*)(ws + W_BTOUT), *BTG = (bf16_t*)(ws + W_BTG), *BTU = (bf16_t*)(ws + W_BTU), *BTD = (bf16_t*)(ws + W_BTD);
    constexpr int J0 = 256, J1 = J0  , J2 = J1 + 32, J3 = J2 + 16, J4 = J3 + 32, J5 = J4 + 176, J6 = J5 + 176, J7 = J6 + 176, J8 = J7 + 48, J9 = J8 + 64;
    bf16_t* XB = (bf16_t*)(ws + W_XB); float* RX = (float*)(ws + W_RX);
    int rowA = b * 8 + wid; f32x4 rv[2][4]; int rrow[2] = {0, 0};
#define ROWS_LOAD() do { rrow[0] = rowA; rrow[1] = rowA + G * 8 < MT ? rowA + G * 8 : rowA; _Pragma("unroll") for (int q = 0; q < 2; ++q) { \
        const float* xr = rrow[q] < NPR ? p->in[0] + (size_t)rrow[q] * DM : p->in[1] + (size_t)(rrow[q] - NPR) * DM; _Pragma("unroll") for (int j = 0; j < 4; ++j) rv[q][j] = __builtin_nontemporal_load((const f32x4*)(xr + j * 256 + lane * 4)); } } while (0)
#define ROWS_FINISH() do { _Pragma("unroll") for (int q = 0; q < 2; ++q) { float ss = 0.f; \
        _Pragma("unroll") for (int j = 0; j < 4; ++j) ss += (rv[q][j][0] * rv[q][j][0] + rv[q][j][1] * rv[q][j][1]) + (rv[q][j][2] * rv[q][j][2] + rv[q][j][3] * rv[q][j][3]); \
        ss = wave_sum(ss); if (lane == 0) RX[rrow[q]] = rsqrtf(ss * (1.0f / 1024.0f) + EPS); \
        _Pragma("unroll") for (int j = 0; j < 4; ++j) { u32x2 w; w.x = cvtpk(rv[q][j][0], rv[q][j][1]); w.y = cvtpk(rv[q][j][2], rv[q][j][3]); *(u32x2*)(XB + (size_t)rrow[q] * DM + j * 256 + lane * 4) = w; } } rowA += 2 * G * 8; } while (0)
    for (int t = b; t < J9; t += G) {
        const bool hasrow = rowA < MT; if (hasrow) ROWS_LOAD();
        if (t < J0) { const int j = t, k0 = (j & 15) * 64, n0 = (j >> 4) * 64; tile_mm<16>(MmVA{w_in, x_in, k0, n0 >> 8}, MmVB{cs, n0}, BT1 + (size_t)512 * 1024, 1024, k0, n0, tile, As, Bs, tid); }
        else if (t < J2) { const int j = t - J1; ttile128(w_in, NIN, x_in, BT1, 1024, (j & 7) * 128, (j >> 3) * 128, (j >> 3) * 128, tile, tid); }
        else if (t < J3) { const int j = t - J2; ttile128(w_ukv, 1024, g_kv, BT2KV, 256, (j & 1) * 128, (j >> 1) * 128, (j >> 1) * 128, tile, tid); }
        else if (t < J4) { const int j = t - J3; ttile128(w_out, 1024, nullptr, BTOUT, 1024, (j & 3) * 128, (j >> 2) * 128, (j >> 2) * 128, tile, tid); }
        else if (t < J5) { const int j = t - J4; ttile128(w_gate, DFF, g_pre_ffn, BTG, 1024, (j & 7) * 128, (j >> 3) * 128, (j >> 3) * 256, tile, tid); }
        else if (t < J6) { const int j = t - J5; ttile128(w_up, DFF, g_pre_ffn, BTG, 1024, (j & 7) * 128, (j >> 3) * 128, (j >> 3) * 256 + 128, tile, tid); }
        else if (t < J7) { const int j = t - J6; ttile128(w_down, 1024, nullptr, BTD, DFF, (j % 22) * 128, (j / 22) * 128, (j / 22) * 128, tile, tid); }
        else if (t < J8) { const int j = t - J7; ttile(SrcQ{w_uq, g_q}, BT2Q, 256, (j & 3) * 64, (j >> 2) * 64, tile); }
        else { const int j = t - J8; ttile(SrcKR{w_in, x_in}, BT1 + (size_t)1536 * 1024, 1024, (j & 15) * 64, (j >> 4) * 64, tile); }
        if (hasrow) ROWS_FINISH();
    }
    { float* RCOS = (float*)(ws + W_RCOS); float* RSIN = (float*)(ws + W_RSIN); float* TW = (float*)(ws + W_TW);
      bf16_t* F1 = (bf16_t*)(ws + W_F1); bf16_t* F2A = (bf16_t*)(ws + W_F2A); bf16_t* F2B = (bf16_t*)(ws + W_F2B);
      constexpr int E0 = 8192 * 16, E1 = E0 + 8192, E2 = E1 + 128 * 128, E3 = E2 + 128 * 256, E4 = E3 + 64 * 128;
      for (int e = b * 512 + tid; e < E4; e += G * 512) {
          if (e < E0) { const int pos = e >> 4, j = e & 15; const float inv = powf(10000.0f, -(float)j * (1.0f / 16.0f)); const float ang = (float)pos * inv; float s, c; sincosf(ang, &s, &c); RCOS[e] = c; RSIN[e] = s; }
          else if (e < E1) { const int m = e - E0; float s, c; sincospif((float)m * (1.0f / 4096.0f), &s, &c); TW[2 * m] = c; TW[2 * m + 1] = s; }
          else if (e < E2) { const int i = e - E1, mm = i >> 7, kx = i & 127, k1 = mm >> 1, ro = mm & 1, n1 = kx >> 1, ri = kx & 1; float s, c; sincospif((float)((n1 * k1) & 63) * (1.0f / 32.0f), &s, &c);
              const float v = (ro == ri) ? c : (ro == 0 ? s : -s); F1[i] = f2bf(v * 0.125f); }
          else if (e < E3) { const int i = e - E2, k2 = i >> 8, kx = i & 255, n2 = kx >> 1, ri = kx & 1; float s, c; sincospif((float)((n2 * k2) & 127) * (1.0f / 64.0f), &s, &c); F2A[i] = f2bf((ri ? s : c) * 0.08838834764831845f); }
          else { const int i = e - E3, k2 = i >> 7, kx = i & 127, n2 = kx >> 1, ri = kx & 1; float s, c; sincospif((float)((n2 * k2) & 63) * (1.0f / 32.0f), &s, &c); F2B[i] = f2bf((ri ? s : c) * 0.125f); }
      } }
    for (; rowA < MT;) { ROWS_LOAD(); ROWS_FINISH(); }
#undef ROWS_LOAD
#undef ROWS_FINISH
}

__device__ __forceinline__ void fold_fnet_tiles(KP p, unsigned char* shm) {
    KP_OPAQUE(p); int tid_ = threadIdx.x; asm volatile("" : "+v"(tid_));
    const int tid = tid_, G = gridDim.x, b = blockIdx.x, half = G / 2 > 0 ? G / 2 : 1; unsigned char* ws = p->ws;
    float* tile = (float*)shm; float* As = (float*)(shm + 32768); float* Bs = (float*)(shm + 32768 + 64 * 132 * 4);
    const float *w_fnet = p->in[8], *w_out = p->in[9]; bf16_t* BTOUT = (bf16_t*)(ws + W_BTOUT);
    __syncthreads();
    for (int j = b - half; j >= 0 && j < 128; j += half) { const int kb = (j & 7) * 64, n0 = (j >> 3) * 64; tile_mm<2>(MmFA{w_fnet, kb}, MmFB{w_out, kb >> 7, n0}, BTOUT, 1024, 512 + kb, n0, tile, As, Bs, tid); }
}

__device__ __forceinline__ void load_x1(KP p, const unsigned char* ws, int row, int lane, const f32x4 (&gpm)[4], f32x4 (&x1)[4]) {
    const float* xr = row < NPR ? p->in[0] + (size_t)row * DM : p->in[1] + (size_t)(row - NPR) * DM;
    const bf16_t* mr = (const bf16_t*)(ws + W_MIX) + (size_t)row * DM; const float* ssp = (const float*)(ws + W_SS2) + (size_t)row * 16;
    const f32x4 s0 = *(const f32x4*)ssp, s1 = *(const f32x4*)(ssp + 4), s2 = *(const f32x4*)(ssp + 8), s3 = *(const f32x4*)(ssp + 12); const f32x4 st = (s0 + s1) + (s2 + s3);
    const float rm = rsqrtf(((st[0] + st[1]) + (st[2] + st[3])) * (1.0f / 1024.0f) + EPS);
#pragma unroll
    for (int j = 0; j < 4; ++j) { const f32x4 xv = __builtin_nontemporal_load((const f32x4*)(xr + j * 256 + lane * 4)); const u32x2 mw = __builtin_nontemporal_load((const u32x2*)(mr + j * 256 + lane * 4));
        const f32x4 mv = {bflo(mw.x), bfhi(mw.x), bflo(mw.y), bfhi(mw.y)}; x1[j] = xv + mv * rm * gpm[j]; }
}
__device__ __forceinline__ void phase5(KP p, int row_lo, int row_hi, int blk_lo, int nblk) {
    int tid_ = threadIdx.x; asm volatile("" : "+v"(tid_));
    const int tid = tid_, lane = tid & 63, wid = tid >> 6, b = (int)blockIdx.x - blk_lo, G = nblk; unsigned char* ws = p->ws;
    if (b < 0 || b >= nblk) return;
    f32x4 gpm[4];
#pragma unroll
    for (int j = 0; j < 4; ++j) gpm[j] = *(const f32x4*)(p->in[10] + j * 256 + lane * 4);
    bf16_t* XB1 = (bf16_t*)(ws + W_XB); float* R2 = (float*)(ws + W_R2);
    for (int row0 = row_lo + b * 8 + wid; row0 < row_hi; row0 += 2 * G * 8) {
        const int row1 = row0 + G * 8 < row_hi ? row0 + G * 8 : row0;
        f32x4 xa[4], xb[4]; load_x1(p, ws, row0, lane, gpm, xa); load_x1(p, ws, row1, lane, gpm, xb); float sa = 0.f, sb = 0.f;
#pragma unroll
        for (int j = 0; j < 4; ++j) { sa += (xa[j][0] * xa[j][0] + xa[j][1] * xa[j][1]) + (xa[j][2] * xa[j][2] + xa[j][3] * xa[j][3]); sb += (xb[j][0] * xb[j][0] + xb[j][1] * xb[j][1]) + (xb[j][2] * xb[j][2] + xb[j][3] * xb[j][3]); }
        sa = wave_sum(sa); sb = wave_sum(sb);
        if (lane == 0) { R2[row0] = rsqrtf(sa * (1.0f / 1024.0f) + EPS); R2[row1] = rsqrtf(sb * (1.0f / 1024.0f) + EPS); }
#pragma unroll
        for (int j = 0; j < 4; ++j) { u32x2 w; w.x = cvtpk(xa[j][0], xa[j][1]); w.y = cvtpk(xa[j][2], xa[j][3]); *(u32x2*)(XB1 + (size_t)row0 * DM + j * 256 + lane * 4) = w;
            u32x2 v; v.x = cvtpk(xb[j][0], xb[j][1]); v.y = cvtpk(xb[j][2], xb[j][3]); *(u32x2*)(XB1 + (size_t)row1 * DM + j * 256 + lane * 4) = v; }
    }
}
__device__ __forceinline__ void phase9(KP p) {
    int tid_ = threadIdx.x; asm volatile("" : "+v"(tid_));
    const int tid = tid_, lane = tid & 63, wid = tid >> 6, G = gridDim.x, b = blockIdx.x; unsigned char* ws = p->ws;
    f32x4 gpf[4];
#pragma unroll
    for (int j = 0; j < 4; ++j) gpf[j] = *(const f32x4*)(p->in[17] + j * 256 + lane * 4);
    const bf16_t* XB1 = (const bf16_t*)(ws + W_XB); const bf16_t* FFN = (const bf16_t*)(ws + W_MIX); const float* SS3 = (const float*)(ws + W_SS3);
    for (int row0 = b * 8 + wid; row0 < MT; row0 += 2 * G * 8) {
        const int rows[2] = {row0, row0 + G * 8 < MT ? row0 + G * 8 : row0};
        u32x2 xw[2][4], fw[2][4]; f32x4 st[2];
#pragma unroll
        for (int q = 0; q < 2; ++q) { const float* ssp = SS3 + (size_t)rows[q] * 16; const f32x4 s0 = *(const f32x4*)ssp, s1 = *(const f32x4*)(ssp + 4), s2 = *(const f32x4*)(ssp + 8), s3 = *(const f32x4*)(ssp + 12); st[q] = (s0 + s1) + (s2 + s3);
#pragma unroll
            for (int j = 0; j < 4; ++j) { xw[q][j] = __builtin_nontemporal_load((const u32x2*)(XB1 + (size_t)rows[q] * DM + j * 256 + lane * 4)); fw[q][j] = __builtin_nontemporal_load((const u32x2*)(FFN + (size_t)rows[q] * DM + j * 256 + lane * 4)); } }
#pragma unroll
        for (int q = 0; q < 2; ++q) { const float rf = rsqrtf(((st[q][0] + st[q][1]) + (st[q][2] + st[q][3])) * (1.0f / 1024.0f) + EPS);
#pragma unroll
            for (int j = 0; j < 4; ++j) { const f32x4 xv = {bflo(xw[q][j].x), bfhi(xw[q][j].x), bflo(xw[q][j].y), bfhi(xw[q][j].y)}, fv = {bflo(fw[q][j].x), bfhi(fw[q][j].x), bflo(fw[q][j].y), bfhi(fw[q][j].y)};
                __builtin_nontemporal_store(xv + fv * rf * gpf[j], (f32x4*)(p->out + (size_t)rows[q] * DM + j * 256 + lane * 4)); } }
    }
}

__device__ __forceinline__ int crow(int r, int hi) { return (r & 3) + 8 * (r >> 2) + 4 * hi; }
__device__ __forceinline__ bf16x8 ldsB(const unsigned* T, int r0, int n) { u32x4 w = {T[(r0 + 0) * 128 + n], T[(r0 + 1) * 128 + n], T[(r0 + 2) * 128 + n], T[(r0 + 3) * 128 + n]}; return *reinterpret_cast<bf16x8*>(&w); }
__device__ __forceinline__ void fft1_decode(int it, int& chb, int& seqbase, int& N2, int& n2, int& tws) {
    chb = it & 3; const int sn = it >> 2;
    if (sn < 256) { seqbase = (sn >> 7) * 8192; N2 = 128; n2 = sn & 127; tws = 1; } else { const int s2 = sn - 256; seqbase = NPR + (s2 >> 6) * 4096; N2 = 64; n2 = s2 & 63; tws = 2; }
}
__device__ __forceinline__ void fft_stage1(KP p, unsigned char* shm) {
    int tid_ = threadIdx.x; asm volatile("" : "+v"(tid_));
    const int tid = tid_, lane = tid & 63, wid = __builtin_amdgcn_readfirstlane(tid >> 6), l32 = lane & 31, hi = lane >> 5, G = gridDim.x; unsigned char* ws = p->ws;
    const unsigned* VC = (const unsigned*)(ws + W_VC); unsigned* T1 = (unsigned*)(ws + W_XB); const bf16_t* F1 = (const bf16_t*)(ws + W_F1); const float* TW = (const float*)(ws + W_TW);
    unsigned* T = (unsigned*)shm;
    const int mb = wid & 3, cb0 = (wid >> 2) * 2;
    bf16x8 a[8];
#pragma unroll
    for (int ks = 0; ks < 8; ++ks) a[ks] = *(const bf16x8*)(F1 + (32 * mb + l32) * 128 + 16 * ks + 8 * hi);
    u32x4 pre[4];
#define F1_LOAD(it_) do { int chb_, sb_, N2_, n2_, tw_; fft1_decode(it_, chb_, sb_, N2_, n2_, tw_); _Pragma("unroll") for (int i = 0; i < 4; ++i) { const int idx = tid + 512 * i, r = idx >> 5, c4 = idx & 31; \
        pre[i] = *(const u32x4*)(VC + (size_t)(sb_ + N2_ * r + n2_) * 512 + chb_ * 128 + c4 * 4); } } while (0)
    if ((int)blockIdx.x < 2048) F1_LOAD((int)blockIdx.x);
    for (int it = blockIdx.x; it < 2048; it += G) {
        int chb, seqbase, N2, n2, tws; fft1_decode(it, chb, seqbase, N2, n2, tws);
        __syncthreads();
#pragma unroll
        for (int i = 0; i < 4; ++i) { const int idx = tid + 512 * i, r = idx >> 5, c4 = idx & 31; *(u32x4*)(T + r * 128 + c4 * 4) = pre[i]; }
        __syncthreads();
        if (it + G < 2048) F1_LOAD(it + G);
#pragma unroll
        for (int c = 0; c < 2; ++c) { const int n = 32 * (cb0 + c) + l32; f32x16 acc = {};
#pragma unroll
            for (int ks = 0; ks < 8; ++ks) acc = __builtin_amdgcn_mfma_f32_32x32x16_bf16(a[ks], ldsB(T, 8 * ks + 4 * hi, n), acc, 0, 0, 0);
#pragma unroll
            for (int q = 0; q < 4; ++q)
#pragma unroll
                for (int e = 0; e < 2; ++e) { const int k1 = 16 * mb + 4 * q + 2 * hi + e; const float re = acc[4 * q + 2 * e], im = acc[4 * q + 2 * e + 1];
                    const int ti = (n2 * k1 * tws) & 8191; const float cc = TW[2 * ti], sn_ = TW[2 * ti + 1];
                    T1[(size_t)(seqbase + k1 * N2 + n2) * 512 + chb * 128 + n] = cvtpk(re * cc + im * sn_, im * cc - re * sn_); } }
    }
#undef F1_LOAD
    __syncthreads();
}
template <int N2> __device__ __forceinline__ void fft_stage2_loop(KP p, unsigned* T, int it0, int it_end, int tid, int wid, int l32, int hi) {
    unsigned char* ws = p->ws; const unsigned* T1 = (const unsigned*)(ws + W_XB); bf16_t* AF = (bf16_t*)(ws + W_AF);
    const bf16_t* F2 = (const bf16_t*)(ws + (N2 == 128 ? W_F2A : W_F2B)); const int G = gridDim.x;
    constexpr int NL = N2 / 16, NMB = N2 / 32, NCB = (N2 == 128) ? 2 : 1, KS = N2 / 8;
    const int mb = wid & (NMB - 1), cbase = (N2 == 128) ? (wid >> 2) * 2 : (wid >> 1);
    u32x4 pre[NL];
#define F2_LOAD(it_) do { const int chb_ = (it_) & 3, k1_ = ((it_) >> 2) & 63, sq_ = (it_) >> 8, sb_ = (N2 == 128) ? sq_ * 8192 : NPR + (sq_ - 2) * 4096; _Pragma("unroll") for (int i = 0; i < NL; ++i) { const int idx = tid + 512 * i, r = idx >> 5, c4 = idx & 31; \
        pre[i] = *(const u32x4*)(T1 + (size_t)(sb_ + k1_ * N2 + r) * 512 + chb_ * 128 + c4 * 4); } } while (0)
    if (it0 < it_end) F2_LOAD(it0);
    for (int it = it0; it < it_end; it += G) { const int chb = it & 3, k1 = (it >> 2) & 63, sq = it >> 8, seqbase = (N2 == 128) ? sq * 8192 : NPR + (sq - 2) * 4096;
        __syncthreads();
#pragma unroll
        for (int i = 0; i < NL; ++i) { const int idx = tid + 512 * i, r = idx >> 5, c4 = idx & 31; *(u32x4*)(T + r * 128 + c4 * 4) = pre[i]; }
        __syncthreads();
        if (it + G < it_end) F2_LOAD(it + G);
#pragma unroll
        for (int c = 0; c < NCB; ++c) { const int n = 32 * (cbase + c) + l32; f32x16 acc = {};
#pragma unroll
            for (int ks = 0; ks < KS; ++ks) { const bf16x8 a = *(const bf16x8*)(F2 + (32 * mb + l32) * (2 * N2) + 16 * ks + 8 * hi);
                acc = __builtin_amdgcn_mfma_f32_32x32x16_bf16(a, ldsB(T, 8 * ks + 4 * hi, n), acc, 0, 0, 0); }
#pragma unroll
            for (int r = 0; r < 16; ++r) { const int k2 = 32 * mb + crow(r, hi); AF[(size_t)(seqbase + k1 + 64 * k2) * 1024 + 512 + chb * 128 + n] = f2bf(acc[r]); } }
    }
#undef F2_LOAD
    __syncthreads();
}
__device__ __forceinline__ void fft_stage2(KP p, unsigned char* shm) {
    int tid_ = threadIdx.x; asm volatile("" : "+v"(tid_));
    const int tid = tid_, lane = tid & 63, wid = __builtin_amdgcn_readfirstlane(tid >> 6), l32 = lane & 31, hi = lane >> 5, G = gridDim.x;
    unsigned* T = (unsigned*)shm;
    __syncthreads();
    fft_stage2_loop<128>(p, T, (int)blockIdx.x, 512, tid, wid, l32, hi);
    { int it0 = blockIdx.x; while (it0 < 512) it0 += G; fft_stage2_loop<64>(p, T, it0, 1536, tid, wid, l32, hi); }
}

namespace att {
constexpr int KVBLK = 64, SHM_V = 8192, SHM_K = 16384;
constexpr float THRL = 11.5f;
#define KSWZ(row, colB) ((row) * 256 + ((colB) ^ (((row) & 15) << 4)))
#define SBAR() __builtin_amdgcn_sched_barrier(0)
template <bool FIRST> __device__ __forceinline__ void partialSM(f32x16& p0, f32x16& p1, float& m_reg, float& alpha) {
    float pmax = p0[0];
#pragma unroll
    for (int r = 1; r < 16; ++r) pmax = fmaxf(pmax, p0[r]);
#pragma unroll
    for (int r = 0; r < 16; ++r) pmax = fmaxf(pmax, p1[r]);
    { auto rr = __builtin_amdgcn_permlane32_swap(__float_as_uint(pmax), __float_as_uint(pmax), false, false); pmax = fmaxf(__uint_as_float(rr[0]), __uint_as_float(rr[1])); }
    if (!FIRST && __builtin_expect(__all(pmax <= THRL), 1)) { alpha = 1.f; }
    else { const float d = FIRST ? pmax : fmaxf(pmax, 0.f); alpha = FIRST ? 1.f : __builtin_amdgcn_exp2f(-d); m_reg += d;
#pragma unroll
        for (int r = 0; r < 16; ++r) p0[r] = p0[r] - d;
#pragma unroll
        for (int r = 0; r < 16; ++r) p1[r] = p1[r] - d; }
#pragma unroll
    for (int r = 0; r < 16; ++r) p0[r] = __builtin_amdgcn_exp2f(p0[r]);
}
__device__ __forceinline__ void finishSM(f32x16& p0, f32x16& p1, float alpha, float& l_reg, bf16x8& pa0, bf16x8& pa1, bf16x8& pa2, bf16x8& pa3) {
#pragma unroll
    for (int r = 0; r < 16; ++r) p1[r] = __builtin_amdgcn_exp2f(p1[r]);
    float ps = 0;
#pragma unroll
    for (int r = 0; r < 16; ++r) ps += p0[r];
#pragma unroll
    for (int r = 0; r < 16; ++r) ps += p1[r];
    { auto rr = __builtin_amdgcn_permlane32_swap(__float_as_uint(ps), __float_as_uint(ps), false, false); ps = __uint_as_float(rr[0]) + __uint_as_float(rr[1]); }
    l_reg = l_reg * alpha + ps;
#define PK4(P, BASE, OUT) do { unsigned a0 = cvtpk(P[BASE + 0], P[BASE + 1]), a1 = cvtpk(P[BASE + 2], P[BASE + 3]);   \
    unsigned b0 = cvtpk(P[BASE + 4], P[BASE + 5]), b1 = cvtpk(P[BASE + 6], P[BASE + 7]);                              \
    auto r0 = __builtin_amdgcn_permlane32_swap(a0, b0, false, false); auto r1 = __builtin_amdgcn_permlane32_swap(a1, b1, false, false); \
    u32x4 w = {r0[0], r1[0], r0[1], r1[1]}; OUT = *reinterpret_cast<bf16x8*>(&w); } while (0)
    PK4(p0, 0, pa0); PK4(p0, 8, pa1); PK4(p1, 0, pa2); PK4(p1, 8, pa3);
#undef PK4
}
__device__ __forceinline__ void qkt(f32x16& p0, f32x16& p1, const char* Ks, const bf16x8* qr, int r32, int hi, float minit) {
#pragma unroll
    for (int r = 0; r < 16; ++r) { p0[r] = minit; p1[r] = minit; }
#pragma unroll
    for (int d0 = 0; d0 < 6; ++d0) { const int cb = (d0 * 16 + hi * 8) * 2;
        bf16x8 b0 = *reinterpret_cast<const bf16x8*>(Ks + KSWZ(r32, cb));
        bf16x8 b1 = *reinterpret_cast<const bf16x8*>(Ks + KSWZ(32 + r32, cb));
        p0 = __builtin_amdgcn_mfma_f32_32x32x16_bf16(b0, qr[d0], p0, 0, 0, 0);
        p1 = __builtin_amdgcn_mfma_f32_32x32x16_bf16(b1, qr[d0], p1, 0, 0, 0); }
}
__device__ __forceinline__ int v_st(int k, int c) { const int kk = (k & ~0xC) | ((k & 4) << 1) | ((k & 8) >> 1); return ((kk >> 3) * 2 + (c >> 5)) * 512 + ((kk & 7) * 32 + (c & 31)) * 2; }
__device__ __forceinline__ int v_rd_base(int lane) { return ((lane & 3) << 3) | (((lane >> 2) & 3) << 6) | (((lane >> 4) & 1) << 5) | (((lane >> 5) & 1) << 8); }
constexpr int v_rd_off(int d0, int ks, int half) { return d0 * 512 + ks * 2048 + half * 1024; }
template <int OFF> __device__ __forceinline__ s16x4 tr_read(int vb) { s16x4 r; asm volatile("ds_read_b64_tr_b16 %0, %1 offset:%2" : "=&v"(r) : "v"(vb), "i"(OFF) : "memory"); return r; }
template <int D0> __device__ __forceinline__ void pv_one(f32x16& od, int vb, bf16x8 pa0, bf16x8 pa1, bf16x8 pa2, bf16x8 pa3) {
    const s16x4 l0 = tr_read<v_rd_off(D0, 0, 0)>(vb), h0 = tr_read<v_rd_off(D0, 0, 1)>(vb), l1 = tr_read<v_rd_off(D0, 1, 0)>(vb), h1 = tr_read<v_rd_off(D0, 1, 1)>(vb);
    const s16x4 l2 = tr_read<v_rd_off(D0, 2, 0)>(vb), h2 = tr_read<v_rd_off(D0, 2, 1)>(vb), l3 = tr_read<v_rd_off(D0, 3, 0)>(vb), h3 = tr_read<v_rd_off(D0, 3, 1)>(vb);
    asm volatile("s_waitcnt lgkmcnt(0)" ::: "memory"); SBAR();
#define PK(L, H) (bf16x8){L[0], L[1], L[2], L[3], H[0], H[1], H[2], H[3]}
    od = __builtin_amdgcn_mfma_f32_32x32x16_bf16(pa0, PK(l0, h0), od, 0, 0, 0);
    od = __builtin_amdgcn_mfma_f32_32x32x16_bf16(pa1, PK(l1, h1), od, 0, 0, 0);
    od = __builtin_amdgcn_mfma_f32_32x32x16_bf16(pa2, PK(l2, h2), od, 0, 0, 0);
    od = __builtin_amdgcn_mfma_f32_32x32x16_bf16(pa3, PK(l3, h3), od, 0, 0, 0);
#undef PK
}
__device__ __forceinline__ void pv_d0(f32x16* o, int vb, bf16x8 pa0, bf16x8 pa1, bf16x8 pa2, bf16x8 pa3) { pv_one<0>(o[0], vb, pa0, pa1, pa2, pa3); pv_one<1>(o[1], vb, pa0, pa1, pa2, pa3); }

__device__ __forceinline__ void body(const bf16_t* __restrict__ Qb, const bf16_t* __restrict__ KNh, const bf16_t* __restrict__ KRs, const bf16_t* __restrict__ Vh, bf16_t* __restrict__ Ob, int seq, char* lds, int qpos0, const float* RCOS, const float* RSIN) {
    int tid_ = threadIdx.x; asm volatile("" : "+v"(tid_));
    const int tid = tid_, wid = __builtin_amdgcn_readfirstlane(tid >> 6), lane = tid & 63, r32 = lane & 31, hi = lane >> 5;
    char* V_lds = lds; char* K_lds = lds + 3 * SHM_V;
    float* wsf = (float*)(lds + 3 * SHM_V + 3 * SHM_K) + wid * 64; float* li_l = wsf; float* al_l = wsf + 32;
    float m_reg = 0.f, l_reg = 0; f32x16 o[2] = {}; bf16x8 qr[6];
    const bf16_t* Qw = Qb + (size_t)(wid * 32 + r32) * 96 + hi * 8;
#pragma unroll
    for (int d0 = 0; d0 < 6; ++d0) qr[d0] = *(const bf16x8*)(Qw + d0 * 16);
#pragma unroll
    for (int d0 = 4; d0 < 6; ++d0) { const int i4 = (2 * (d0 - 4) + hi) * 4, pos = qpos0 + wid * 32 + r32; const f32x4 c4 = *(const f32x4*)(RCOS + pos * 16 + i4), s4 = *(const f32x4*)(RSIN + pos * 16 + i4);
        const u32x4 w = *reinterpret_cast<const u32x4*>(&qr[d0]); const f32x4 x1 = {bflo(w.x), bfhi(w.x), bflo(w.y), bfhi(w.y)}, x2 = {bflo(w.z), bfhi(w.z), bflo(w.w), bfhi(w.w)};
        const u32x4 o = pack8(x1 * c4 - x2 * s4, x2 * c4 + x1 * s4); qr[d0] = *reinterpret_cast<const bf16x8*>(&o); }
    const int vr = tid >> 3, vc = (tid & 7) * 8, vst = v_st(vr, vc);
    const char* vp = (const char*)(Vh + (size_t)vr * 64 + vc);
    const int cA = tid, rA = cA / 12, pA = cA - rA * 12; const int cB = 512 + (tid & 255), rB = cB / 12, pB = cB - rB * 12;
    const char* kpA = pA < 8 ? (const char*)(KNh + (size_t)rA * 64 + pA * 8) : (const char*)(KRs + (size_t)rA * 32 + (pA - 8) * 8); const size_t ksA = pA < 8 ? 8192 : 4096; const int kdA = KSWZ(rA, pA * 16);
    const bool hasB = wid < 4;
    const char* kpB = !hasB ? kpA : (pB < 8 ? (const char*)(KNh + (size_t)rB * 64 + pB * 8) : (const char*)(KRs + (size_t)rB * 32 + (pB - 8) * 8)); const size_t ksB = !hasB ? ksA : (pB < 8 ? 8192 : 4096); const int kdB = !hasB ? kdA : KSWZ(rB, pB * 16);
    const int vb0 = (int)(uintptr_t)V_lds + v_rd_base(lane);
    struct { bf16x8 vs, ka, kb; } sr_[2];
#define SLOAD(i, j) do { sr_[i].vs = *(const bf16x8*)(vp + (size_t)(j) * 8192); sr_[i].ka = *(const bf16x8*)(kpA + (size_t)(j) * ksA); sr_[i].kb = *(const bf16x8*)(kpB + (size_t)(j) * ksB); } while (0)
#define SWRITE(b, i) do { *(bf16x8*)(V_lds + (b) * SHM_V + vst) = sr_[i].vs; *(bf16x8*)(K_lds + (b) * SHM_K + kdA) = sr_[i].ka; *(bf16x8*)(K_lds + (b) * SHM_K + kdB) = sr_[i].kb; } while (0)
#define RESC(a) do { if (__any((a) < 1.f)) { if (hi == 0) al_l[r32] = (a); asm volatile("s_waitcnt lgkmcnt(0)" ::: "memory"); \
    _Pragma("unroll") for (int d = 0; d < 2; ++d) _Pragma("unroll") for (int r = 0; r < 16; ++r) o[d][r] *= al_l[crow(r, hi)]; } } while (0)
#define NEXT3(x) ((x) == 2 ? 0 : (x) + 1)
    f32x16 pA0, pA1, pB0, pB1; float alA, alB; bf16x8 pa0, pa1, pa2, pa3; const int NT = seq / KVBLK;
    __syncthreads();
    SLOAD(0, 0); SLOAD(1, 1); asm volatile("s_waitcnt vmcnt(3)" ::: "memory"); SWRITE(0, 0); SLOAD(0, 2);
    __syncthreads();
    qkt(pA0, pA1, K_lds, qr, r32, hi, 0.f); partialSM<true>(pA0, pA1, m_reg, alA);
    SWRITE(1, 1); SLOAD(1, 3);
    int bc = 1;
    for (int j = 1; j + 1 < NT; j += 2) {
        { const int bn = NEXT3(bc), bp = (bc == 0 ? 2 : bc - 1);
          __syncthreads();
          SBAR(); qkt(pB0, pB1, K_lds + bc * SHM_K, qr, r32, hi, -m_reg);
          finishSM(pA0, pA1, alA, l_reg, pa0, pa1, pa2, pa3); SBAR();
          pv_d0(o, vb0 + bp * SHM_V, pa0, pa1, pa2, pa3); partialSM<false>(pB0, pB1, m_reg, alB);
          SBAR(); SWRITE(bn, 0); SLOAD(0, (j + 3 < NT ? j + 3 : NT - 1));
          RESC(alB); bc = bn; }
        { const int bn = NEXT3(bc), bp = (bc == 0 ? 2 : bc - 1);
          __syncthreads();
          SBAR(); qkt(pA0, pA1, K_lds + bc * SHM_K, qr, r32, hi, -m_reg);
          finishSM(pB0, pB1, alB, l_reg, pa0, pa1, pa2, pa3); SBAR();
          pv_d0(o, vb0 + bp * SHM_V, pa0, pa1, pa2, pa3); partialSM<false>(pA0, pA1, m_reg, alA);
          SBAR(); SWRITE(bn, 1); SLOAD(1, (j + 4 < NT ? j + 4 : NT - 1));
          RESC(alA); bc = bn; }
    }
    { const int bp = (bc == 0 ? 2 : bc - 1);
      __syncthreads();
      SBAR(); qkt(pB0, pB1, K_lds + bc * SHM_K, qr, r32, hi, -m_reg);
      finishSM(pA0, pA1, alA, l_reg, pa0, pa1, pa2, pa3); SBAR();
      pv_d0(o, vb0 + bp * SHM_V, pa0, pa1, pa2, pa3); partialSM<false>(pB0, pB1, m_reg, alB);
      RESC(alB);
      finishSM(pB0, pB1, alB, l_reg, pa0, pa1, pa2, pa3); SBAR();
      pv_d0(o, vb0 + bc * SHM_V, pa0, pa1, pa2, pa3); }
    asm volatile("s_waitcnt vmcnt(0)" ::: "memory");
    if (hi == 0) li_l[r32] = l_reg; asm volatile("s_waitcnt lgkmcnt(0)" ::: "memory");
    float rli[16];
#pragma unroll
    for (int r = 0; r < 16; ++r) rli[r] = __builtin_amdgcn_rcpf(li_l[crow(r, hi)]);
    bf16_t* Ow = Ob + (size_t)(wid * 32) * 1024;
#pragma unroll
    for (int r = 0; r < 16; ++r) { const int orow = crow(r, hi);
#pragma unroll
        for (int d0 = 0; d0 < 2; ++d0) Ow[(size_t)orow * 1024 + d0 * 32 + r32] = f2bf(o[d0][r] * rli[r]); }
#undef SLOAD
#undef SWRITE
#undef RESC
#undef NEXT3
}
}

__device__ __forceinline__ void attn_phase(KP p, unsigned char* shm) {
    const int G = gridDim.x, b = blockIdx.x; unsigned char* ws = p->ws; unsigned char* od = (unsigned char*)p->out;
    const bf16_t* Q = (const bf16_t*)(od + O_Q); const bf16_t* KN = (const bf16_t*)(od + O_KN); const bf16_t* VV = (const bf16_t*)(od + O_VV); const bf16_t* KRP = (const bf16_t*)(ws + W_KRP); bf16_t* AF = (bf16_t*)(ws + W_AF);
    for (int it = b; it < 1024; it += G) {
        int pair, qb, seqbase, len, head;
        if (G == 256) { const int j = it >> 8, xcd = b & 7, slot = b >> 3;
            if (j < 2) { pair = j * 8 + xcd; qb = slot; seqbase = (pair >> 3) * 8192; len = 8192; }
            else { pair = (j - 2) * 16 + 2 * xcd + (slot >> 4); qb = slot & 15; seqbase = NPR + (pair >> 3) * 4096; len = 4096; }
        } else if (it < 512) { pair = it >> 5; qb = it & 31; seqbase = (pair >> 3) * 8192; len = 8192; }
        else { const int i2 = it - 512; pair = i2 >> 4; qb = i2 & 15; seqbase = NPR + (pair >> 3) * 4096; len = 4096; }
        head = pair & 7;
        att::body(Q + ((size_t)head * MT + seqbase + qb * 256) * 96, KN + ((size_t)head * MT + seqbase) * 64, KRP + (size_t)seqbase * 32, VV + ((size_t)head * MT + seqbase) * 64,
                  AF + (size_t)(seqbase + qb * 256) * 1024 + head * 64, len, (char*)shm, qb * 256, (const float*)(ws + W_RCOS), (const float*)(ws + W_RSIN));
    }
}


#ifndef DBG_STOP
#define DBG_STOP 0
#endif
__device__ __forceinline__ float bfv(const bf16_t* p, size_t i) { return __uint_as_float(((unsigned)p[i]) << 16); }
__device__ __forceinline__ void dbg_probe(KP p, int k) {
    unsigned char* ws = p->ws; float* out = p->out; const size_t n = (size_t)MT * DM;
    for (size_t i = (size_t)blockIdx.x * 512 + threadIdx.x; i < n; i += (size_t)gridDim.x * 512) { const size_t row = i >> 10; const int c = (int)(i & 1023); float v = 0.f;
        if (k == 1) v = bfv((const bf16_t*)(ws + W_VC), i) + bfv((const bf16_t*)(ws + W_CQ), row * 256 + (c & 255)) + bfv((const bf16_t*)(ws + W_CKV), row * 256 + (c & 255)) + bfv((const bf16_t*)(ws + W_KRP), row * 32 + (c & 31)) + ((const float*)(ws + W_SSP))[row * 8 + (c & 7)];
        if (k == 10) v = bfv((const bf16_t*)(ws + W_XB), i) + ((const float*)(ws + W_RX))[row];
        if (k == 11) v = bfv((const bf16_t*)(ws + W_BT1), i) + bfv((const bf16_t*)(ws + W_BTOUT), i) + bfv((const bf16_t*)(ws + W_BTG), i % ((size_t)DFF * 1024)) + bfv((const bf16_t*)(ws + W_BTD), i % ((size_t)DFF * 1024)) + bfv((const bf16_t*)(ws + W_BT2Q), i % (768 * 256)) + ((const float*)(ws + W_RCOS))[i % (8192 * 16)] + ((const float*)(ws + W_TW))[i % 16384] + bfv((const bf16_t*)(ws + W_F2A), i % 32768);
        if (k == 2) v = bfv((const bf16_t*)(ws + W_XB), i);
        if (k == 3) v = bfv((const bf16_t*)(ws + W_AF), i);
        if (k == 4) v = bfv((const bf16_t*)(ws + W_MIX), i) + ((const float*)(ws + W_SS2))[row * 16 + (c & 15)];
        if (k == 5) v = bfv((const bf16_t*)(ws + W_XB), i) + ((const float*)(ws + W_R2))[row];
        if (k == 8) v = bfv((const bf16_t*)(ws + W_XB), i) + ((const float*)(ws + W_SS3))[row * 16 + (c & 15)];
        out[i] = v; }
}
__device__ __forceinline__ void dbg_probe_qkv(KP p, int step) {
    unsigned char* ws = p->ws; float* out = p->out; const size_t n = (size_t)MT * DM; float* tmp = (float*)(ws + 96 * MiB); const unsigned char* od = (const unsigned char*)p->out;
    for (size_t i = (size_t)blockIdx.x * 512 + threadIdx.x; i < n; i += (size_t)gridDim.x * 512) {
        if (step == 0) { float v = bfv((const bf16_t*)od, i); if (i < (size_t)24 * 1048576) v += bfv((const bf16_t*)(od + 64 * MiB), i); tmp[i] = v; }
        else out[i] = tmp[i]; }
}
#define XB_TMO      128
#define XB_XCNT(j)  (256  + 64 * (j))
#define XB_XSUB(j)  (1280 + 64 * (j))
#define XB_XGEN(j)  (2304 + 64 * (j))
#define XB_TOP      3328
#define XB_TOPGEN   3392
#define XCD_BAR_WORDS 3456
#define XB_SPIN_CAP (1u << 18)
#define XLAS __attribute__((address_space(3)))

__device__ __forceinline__ unsigned xb_ld(unsigned* p)              { return __hip_atomic_load(p, __ATOMIC_RELAXED, __HIP_MEMORY_SCOPE_AGENT); }
__device__ __forceinline__ unsigned xb_add(unsigned* p, unsigned v) { return __hip_atomic_fetch_add(p, v, __ATOMIC_RELAXED, __HIP_MEMORY_SCOPE_AGENT); }
__device__ __forceinline__ unsigned xb_xcc_id() { return (unsigned)__builtin_amdgcn_s_getreg((3 << 11) | 20) & 0xFu; }
#define XB_SPIN(cond, bar) do { unsigned _sp = 0; while (cond) { __builtin_amdgcn_s_sleep(1); \
    if ((++_sp & 255u) == 0u) { if (xb_ld(&(bar)[XB_TMO])) break; if (_sp > XB_SPIN_CAP) { atomicAdd(&(bar)[XB_TMO], 1u); break; } } } } while (0)

struct XcdBarrier {
    unsigned* bar; unsigned x;
    volatile XLAS unsigned* st;
};

__device__ __forceinline__ XcdBarrier xcd_barrier_post(unsigned* bar, volatile XLAS unsigned* st) {
    XcdBarrier b; b.bar = bar; b.x = xb_xcc_id(); b.st = st;
    if (threadIdx.x == 0) (void)xb_add(&bar[XB_XCNT(b.x)], 1u);
    return b;
}
__device__ __forceinline__ void xcd_barrier_complete(unsigned* bar, unsigned x, unsigned& nloc, unsigned& nx) {
    const unsigned G = gridDim.x * gridDim.y * gridDim.z;
    unsigned sum, cnt, mine, sp = 0u;
    for (;;) {
        sum = 0u; cnt = 0u; mine = 0u;
#pragma unroll
        for (unsigned j = 0; j < 16; ++j) { const unsigned c = xb_ld(&bar[XB_XCNT(j)]); sum += c; cnt += (c > 0u) ? 1u : 0u; mine = (j == x) ? c : mine; }
        if (sum == G) break;
        __builtin_amdgcn_s_sleep(1);
        if ((++sp & 255u) == 0u) { if (xb_ld(&bar[XB_TMO])) break; if (sp > XB_SPIN_CAP) { atomicAdd(&bar[XB_TMO], 1u); break; } }
    }
    nloc = mine > 0u ? mine : 1u; nx = cnt > 0u ? cnt : 1u;
}

__device__ __forceinline__ void xcd_barrier(const XcdBarrier& b) {
    asm volatile("s_waitcnt vmcnt(0)" ::: "memory");
    __syncthreads();
    if (threadIdx.x == 0) {
        unsigned* bar = b.bar;
        __builtin_amdgcn_s_waitcnt(0);
        unsigned nloc = b.st[0], nx = b.st[1];
        if (nloc == 0u) { xcd_barrier_complete(bar, b.x, nloc, nx); b.st[0] = nloc; b.st[1] = nx; }
        const unsigned old = xb_add(&bar[XB_XSUB(b.x)], 1u);
        const unsigned gen = old / nloc;
        if (old + 1u == (gen + 1u) * nloc) {
            __builtin_amdgcn_fence(__ATOMIC_RELEASE, "agent");
            asm volatile("s_waitcnt vmcnt(0)" ::: "memory");
            const unsigned og = xb_add(&bar[XB_TOP], 1u);
            const unsigned tg = og / nx;
            if (og + 1u == (tg + 1u) * nx) xb_add(&bar[XB_TOPGEN], 1u);
            else XB_SPIN(xb_ld(&bar[XB_TOPGEN]) == tg, bar);
            __builtin_amdgcn_fence(__ATOMIC_ACQUIRE, "agent");
            xb_add(&bar[XB_XGEN(b.x)], 1u);
            asm volatile("s_waitcnt vmcnt(0)" ::: "memory");
        } else {
            XB_SPIN(xb_ld(&bar[XB_XGEN(b.x)]) == gen, bar);
            __builtin_amdgcn_fence(__ATOMIC_ACQUIRE, "agent");
            asm volatile("s_waitcnt vmcnt(0)" ::: "memory");
        }
    }
    __syncthreads();
}

#ifndef OWN_BAR
#define OWN_BAR 1
#endif
#ifndef PHM
#define PHM 0xFFFF
#endif
#ifndef DUPM
#define DUPM 0
#endif
#define PH(n) for (int rep_ = 0; rep_ < 1 + ((DUPM >> (n)) & 1); ++rep_) if constexpr ((PHM >> (n)) & 1)
__global__ void __launch_bounds__(512) mega_fwd(Params p_unused) {
    extern __shared__ __attribute__((aligned(16))) unsigned char shm[];
#if !OWN_BAR
    cg::grid_group grid = cg::this_grid();
#endif
    PG8_LAS unsigned char* lds = (PG8_LAS unsigned char*)shm;
    const int G = gridDim.x, b = blockIdx.x;
    KP p = (KP)__builtin_amdgcn_kernarg_segment_ptr();

#define TSTAMP(k) do { if constexpr (DIAG_A >= 0) { if (blockIdx.x == 0 && threadIdx.x == 0) ((unsigned long long*)(p->ws + W_TS))[k] = wall_clock64(); } } while (0)
#if OWN_BAR
    if (threadIdx.x < 2) ((volatile XLAS unsigned*)(lds + 131072))[threadIdx.x] = 0u;
    __syncthreads();
    { KP_OPAQUE(p); (void)xcd_barrier_post((unsigned*)(p->ws + W_BAR), (volatile XLAS unsigned*)(lds + 131072)); }
#define GRID_SYNC(gen) do { XcdBarrier xb_; xb_.bar = (unsigned*)(p->ws + W_BAR); xb_.x = xb_xcc_id(); xb_.st = (volatile XLAS unsigned*)(lds + 131072); xcd_barrier(xb_); } while (0)
#else
#define GRID_SYNC(gen) do { asm volatile("s_waitcnt vmcnt(0) lgkmcnt(0)" ::: "memory"); grid.sync(); __builtin_amdgcn_fence(__ATOMIC_ACQUIRE, "agent"); asm volatile("s_waitcnt vmcnt(0)" ::: "memory"); } while (0)
#endif
    TSTAMP(0);
    PH(0) phase0(p, shm);
    GRID_SYNC(1); TSTAMP(1);
    if constexpr (DBG_STOP == 10 || DBG_STOP == 11) { dbg_probe(p, DBG_STOP); return; }
    PH(1) { fold_fnet_tiles(p, shm); }
    PH(1) {
        KP_OPAQUE(p); unsigned char* ws = p->ws;
        pg8::Gemm g{(const bf16_t*)(ws + W_XB), (const bf16_t*)(ws + W_BT1), MT, 1792, 1024}; pg8::StaticOrder S; S.init(MT, 1792, G, b);
        Epi1 E{(const float*)(ws + W_RX), (bf16_t*)(ws + W_CQ), (bf16_t*)(ws + W_CKV), (float*)(ws + W_SSP), (bf16_t*)(ws + W_VC), (bf16_t*)(ws + W_KRP), (const float*)(ws + W_RCOS), (const float*)(ws + W_RSIN)};
        pg8::gemm_phase<Epi1, pg8::StaticOrder, GEMM_ALIGN, GEMM_SP2>(lds, g, S, E);
    }
    GRID_SYNC(2); TSTAMP(2);
    if constexpr (DBG_STOP == 1) { dbg_probe(p, 1); return; }
    {
        PH(2) { KP_OPAQUE(p); unsigned char* ws = p->ws; unsigned char* od = (unsigned char*)p->out;
          pg8::Gemm g{(const bf16_t*)(ws + W_CQ), (const bf16_t*)(ws + W_BT2Q), MT, 768, 256}; pg8::StaticOrder S; S.init(MT, 768, G, b);
          Epi2Q E{(const float*)(ws + W_SSP), (bf16_t*)(od + O_Q)}; pg8::gemm_phase<Epi2Q, pg8::StaticOrder, GEMM_ALIGN, false>(lds, g, S, E); }
        PH(3) { KP_OPAQUE(p); unsigned char* ws = p->ws; unsigned char* od = (unsigned char*)p->out;
          pg8::Gemm g{(const bf16_t*)(ws + W_CKV), (const bf16_t*)(ws + W_BT2KV), MT, 1024, 256}; pg8::StaticOrder S; S.init(MT, 1024, G, b);
          Epi2KV E{(const float*)(ws + W_SSP), (bf16_t*)(od + O_KN), (bf16_t*)(od + O_VV)}; pg8::gemm_phase<Epi2KV, pg8::StaticOrder, GEMM_ALIGN, false>(lds, g, S, E); }
        PH(4) { KP_OPAQUE(p); fft_stage1(p, shm); }
    }
    GRID_SYNC(3); TSTAMP(3);
    if constexpr (DBG_STOP == 2) { dbg_probe(p, 2); return; }
    if constexpr (DBG_STOP == 20) { dbg_probe_qkv(p, 0); GRID_SYNC(4); dbg_probe_qkv(p, 1); return; }
    PH(5) { KP_OPAQUE(p); attn_phase(p, shm); }
    TSTAMP(13);
    PH(6) { KP_OPAQUE(p); fft_stage2(p, shm); }
    GRID_SYNC(4); TSTAMP(4);
    if constexpr (DBG_STOP == 3) { dbg_probe(p, 3); return; }
    PH(7) {
        KP_OPAQUE(p); unsigned char* ws = p->ws;
        pg8::Gemm g{(const bf16_t*)(ws + W_AF), (const bf16_t*)(ws + W_BTOUT), MT, 1024, 1024}; pg8::StaticOrder S; S.init(MT, 1024, G, b);
        EpiSS E{(bf16_t*)(ws + W_MIX), (float*)(ws + W_SS2)}; pg8::gemm_phase<EpiSS, pg8::StaticOrder, GEMM_ALIGN, GEMM_SP2>(lds, g, S, E);
    }
    GRID_SYNC(5); TSTAMP(5);
    if constexpr (DBG_STOP == 4) { dbg_probe(p, 4); return; }
    const bool p5split = (G == 256);
    PH(8) { KP_OPAQUE(p); if (p5split) phase5(p, 0, NPR + 8192, 0, G); else phase5(p, 0, MT, 0, G); }
    GRID_SYNC(6); TSTAMP(6);
    if constexpr (DBG_STOP == 5) { dbg_probe(p, 5); return; }
#pragma unroll 1
    for (int h = 0; h < 2; ++h) { const int hb = h * NPR;
        PH(9) { KP_OPAQUE(p); unsigned char* ws = p->ws; unsigned char* od = (unsigned char*)p->out; const bf16_t* XB1h = (const bf16_t*)(ws + W_XB) + (size_t)hb * DM;
          pg8::Gemm g{XB1h, (const bf16_t*)(ws + W_BTG), NPR, 2 * DFF, 1024}; pg8::OverlapOrder S; S.init2(h ? 4096 : 8192, h ? 4 : 2, 2 * DFF, G, b);
          EpiGU E{(const float*)(ws + W_R2), p->in[14], p->in[15], h ? (bf16_t*)(od + O_ACT1) : (bf16_t*)(ws + W_ACT), (PG8_LAS unsigned*)(lds + LDS_X), hb, h ? 4096 : 8192, S.nT};
          pg8::gemm_phase<EpiGU, pg8::OverlapOrder, GEMM_ALIGN, GEMM_SP2>(lds, g, S, E); }
        PH(8) { if (h == 0 && p5split) { KP_OPAQUE(p); phase5(p, NPR + 8192, MT, 172, 84); } }
        GRID_SYNC(7 + 2 * h); TSTAMP(7 + 2 * h);
        PH(11) { KP_OPAQUE(p); unsigned char* ws = p->ws; unsigned char* od = (unsigned char*)p->out;
          pg8::Gemm g{h ? (const bf16_t*)(od + O_ACT1) : (const bf16_t*)(ws + W_ACT), (const bf16_t*)(ws + W_BTD), NPR, 1024, DFF}; pg8::StaticOrder S; S.init(NPR, 1024, G, b);
          EpiSS E{(bf16_t*)(ws + W_MIX) + (size_t)hb * DM, (float*)(ws + W_SS3) + (size_t)hb * 16};     pg8::gemm_phase<EpiSS, pg8::StaticOrder, GEMM_ALIGN, GEMM_SP2>(lds, g, S, E); }
        if (h == 1) { GRID_SYNC(11); TSTAMP(11); }
    }
    if constexpr (DBG_STOP == 8) { dbg_probe(p, 8); return; }
    PH(12) { KP_OPAQUE(p); phase9(p); }
}

extern "C" void kernel_launch(void* const* d_in, const int* in_sizes, int n_in, void* d_out, int out_size, void* d_ws, size_t ws_size, hipStream_t stream) {
    static int grid_blocks = 0;
    if (grid_blocks == 0) {
        if (n_in != 18 || in_sizes[0] != NPR * DM || in_sizes[1] != NPR * DM || out_size != MT * DM || ws_size < W_END) {
            fprintf(stderr, "kernel_launch: unexpected shapes / workspace (n_in %d, ws %zu, need %zu); nothing launched\n", n_in, ws_size, (size_t)W_END); grid_blocks = -1; return; }
        int dev = 0, cus = 0, per_cu = 0;
        (void)hipGetDevice(&dev); (void)hipDeviceGetAttribute(&cus, hipDeviceAttributeMultiprocessorCount, dev);
        if (hipFuncSetAttribute((const void*)mega_fwd, hipFuncAttributeMaxDynamicSharedMemorySize, LDS_BYTES) != hipSuccess) { fprintf(stderr, "kernel_launch: hipFuncSetAttribute failed\n"); grid_blocks = -1; return; }
        if (hipOccupancyMaxActiveBlocksPerMultiprocessor(&per_cu, (const void*)mega_fwd, 512, LDS_BYTES) != hipSuccess || per_cu < 1) { fprintf(stderr, "kernel_launch: occupancy query failed (%d)\n", per_cu); grid_blocks = -1; return; }
        grid_blocks = cus * per_cu; if (grid_blocks > 256) grid_blocks = 256;
    }
    if (grid_blocks < 0) return;
    Params p{};
    for (int i = 0; i < 18; ++i) p.in[i] = (const float*)d_in[i];
    p.out = (float*)d_out; p.ws = (unsigned char*)d_ws;
    if (hipMemsetAsync((char*)d_ws + W_BAR, 0, XCD_BAR_WORDS * 4, stream) != hipSuccess) { fprintf(stderr, "kernel_launch: memset failed\n"); return; }
    void* args[] = {&p};
    hipError_t e = hipLaunchCooperativeKernel((const void*)mega_fwd, dim3(grid_blocks), dim3(512), args, LDS_BYTES, stream);
    if (e != hipSuccess) fprintf(stderr, "kernel_launch: cooperative launch failed: %s (grid %d)\n", hipGetErrorString(e), grid_blocks);
}
```

```cpp
#include <hip/hip_runtime.h>
#include <hip/hip_cooperative_groups.h>
#include <cstdio>
namespace cg = cooperative_groups;

namespace pg8 {
#define PG8_LAS __attribute__((address_space(3)))
typedef unsigned short bf16_t;
typedef short bf16x8 __attribute__((ext_vector_type(8)));
typedef float f32x4 __attribute__((ext_vector_type(4)));
typedef unsigned u32x4 __attribute__((ext_vector_type(4)));
constexpr int BM = 256, BK = 64, HALF = 128, HTB = HALF * BK * 2  , STAGE_BYTES = 8 * HTB, NXCD = 8, WGM = 8;

__host__ __device__ __forceinline__ int lds_byte(int r, int c) { const int st = (r >> 4) * 2 + (c >> 5), rr = r & 15, cc = c & 31, ob = rr * 64 + cc * 2; return st * 1024 + (ob ^ (((ob >> 9) & 1) << 5)); }
__host__ __device__ __forceinline__ void stage_rc(int b, int& R, int& C) { const int st = b / 1024, sb = b % 1024, swz = sb ^ (((sb >> 9) & 1) << 5); R = (st >> 1) * 16 + swz / 64; C = (st & 1) * 32 + (swz % 64) / 2; }
__host__ __device__ __forceinline__ int perm32(int rho) { const int n = rho >> 4, i = rho & 15; return 8 * (i >> 2) + 4 * n + (i & 3); }

struct Unit { int pm, pn; };
struct Gemm { const bf16_t* A; const bf16_t* Bt; int M, N, K; };

struct StaticOrder {
    int nM, nN, nwg, G, c;
    __host__ __device__ void init(int M, int N, int G_, int c_) { nM = M / BM; nN = N / BM; nwg = nM * nN; G = G_; c = c_; }
    __device__ __forceinline__ long long abase(const Unit& u, int K) const { return (long long)u.pm * (BM * 2) * K; }
    __host__ __device__ bool next(int i, Unit& u) const {
        const long L = (long)i * G + c; if (L >= nwg) return false;
        int wgid = (int)L; { const int q = nwg / NXCD, r = nwg % NXCD, xcd = wgid % NXCD, off = wgid / NXCD; wgid = (xcd < r ? xcd * (q + 1) : r * (q + 1) + (xcd - r) * q) + off; }
        const int nig = WGM * nN, gid = wgid / nig, fm = gid * WGM, gsz = (nM - fm) < WGM ? (nM - fm) : WGM;
        u.pm = fm + ((wgid % nig) % gsz); u.pn = (wgid % nig) / gsz; return true;
    }
    __device__ __forceinline__ void a_ready(const Unit&) const {}
    __device__ __forceinline__ void done(const Unit&) const {}
};

struct OverlapOrder : StaticOrder {
    int nT, slen;
    __host__ __device__ void init2(int slen_, int nseq, int N, int G_, int c_) { slen = slen_; nT = (slen_ + 253) / 254; nM = nseq * nT; nN = N / BM; nwg = nM * nN; G = G_; c = c_; }
    __device__ __forceinline__ int rowbase(int pm) const { const int sq = pm / nT, t = pm - sq * nT; return sq * slen + 254 * t - 1; }
    __device__ __forceinline__ long long abase(const Unit& u, int K) const { return (long long)rowbase(u.pm) * 2 * K; }
};

template <class Epi, class Sched, bool ALIGN_EPI = false, bool SP2 = false>
__device__ __forceinline__ void gemm_phase(PG8_LAS unsigned char* lds, const Gemm g, const Sched& S, const Epi& E) {
    int tid_ = threadIdx.x; asm volatile("" : "+v"(tid_));
    const int tid = tid_, wid = __builtin_amdgcn_readfirstlane(tid >> 6), lane = tid & 63, wr = wid >> 2, wc = wid & 3, fr = lane & 15, fq = lane >> 4;
    const int K = g.K, nt = K / BK;
    unsigned voffA[2], voffB[2];
#pragma unroll
    for (int i = 0; i < 2; ++i) { int R, C; stage_rc(tid * 16 + i * 8192, R, C); const int Rb = Epi::PERM ? ((R & ~31) + perm32(R & 31)) : R;
        voffA[i] = (unsigned)(R * K + C) * 2u; voffB[i] = (unsigned)(Rb * K + C) * 2u; }
    const size_t kstep = (size_t)(BK * 2);
    const size_t hstep = (size_t)HALF * K * 2;
    const size_t tstep = 2 * hstep;
    const unsigned ldsw = (unsigned)wid * 1024u;
    const int aoff = lds_byte(wr * 64 + fr, fq * 8), boff = lds_byte(wc * 32 + fr, fq * 8);
#define PG8_SA(b, h) (((b) * 2 + (h)) * HTB)
#define PG8_SB(b, h) ((4 + (b) * 2 + (h)) * HTB)
#define PG8_STAGE(bufoff, gbase, voff) do { _Pragma("unroll") for (int _i = 0; _i < 2; ++_i) \
        __builtin_amdgcn_global_load_lds((const unsigned*)((const char*)(gbase) + (voff)[_i]), (PG8_LAS unsigned*)(lds + (bufoff) + ldsw + _i * 8192), 16, 0, 0); } while (0)
#define PG8_LDA(dst, b, h) do { _Pragma("unroll") for (int m = 0; m < 4; ++m) _Pragma("unroll") for (int k = 0; k < 2; ++k) dst[m][k] = *(const PG8_LAS bf16x8*)(lds + PG8_SA(b, h) + aoff + m * 2048 + k * 1024); } while (0)
#define PG8_LDB(dst, b, h) do { _Pragma("unroll") for (int n = 0; n < 2; ++n) _Pragma("unroll") for (int k = 0; k < 2; ++k) dst[n][k] = *(const PG8_LAS bf16x8*)(lds + PG8_SB(b, h) + boff + n * 2048 + k * 1024); } while (0)
#define PG8_MMA(ai, bj, At, Bt) do { __builtin_amdgcn_s_setprio(1); _Pragma("unroll") for (int m = 0; m < 4; ++m) _Pragma("unroll") for (int n = 0; n < 2; ++n) _Pragma("unroll") for (int k = 0; k < 2; ++k) \
        acc[ai][bj][m][n] = __builtin_amdgcn_mfma_f32_16x16x32_bf16(Bt[n][k], At[m][k], acc[ai][bj][m][n], 0, 0, 0); __builtin_amdgcn_s_setprio(0); } while (0)
#define PG8_WAIT_V(n) asm volatile("s_waitcnt vmcnt(" #n ")" ::: "memory")
#define PG8_WAIT_L(n) asm volatile("s_waitcnt lgkmcnt(" #n ")" ::: "memory")
#define PG8_BAR __builtin_amdgcn_s_barrier()
#define PG8_SCHED __builtin_amdgcn_sched_barrier(0)
    Unit cur, nxt; int ui = 0;
    if (!S.next(0, cur)) return;
    f32x4 acc[2][2][4][2];
#pragma unroll
    for (int a = 0; a < 2; ++a)
#pragma unroll
        for (int b = 0; b < 2; ++b)
#pragma unroll
            for (int m = 0; m < 4; ++m)
#pragma unroll
                for (int n = 0; n < 2; ++n) acc[a][b][m][n] = (f32x4){0.f, 0.f, 0.f, 0.f};
    bf16x8 At[4][2], B0[2][2], B1[2][2];
    const char* cA = (const char*)g.A + S.abase(cur, K); const char* cB = (const char*)g.Bt + (size_t)cur.pn * tstep;
    S.a_ready(cur);
    if constexpr (SP2) {
        PG8_STAGE(PG8_SB(0, 0), cB, voffB); PG8_STAGE(PG8_SB(0, 1), cB + hstep, voffB); PG8_STAGE(PG8_SA(0, 0), cA, voffA); PG8_STAGE(PG8_SA(0, 1), cA + hstep, voffA);
        if (wr == 1) PG8_BAR;
        PG8_WAIT_V(2); PG8_BAR;
        PG8_STAGE(PG8_SB(1, 0), cB + kstep, voffB); PG8_STAGE(PG8_SA(1, 0), cA + kstep, voffA); PG8_STAGE(PG8_SB(1, 1), cB + hstep + kstep, voffB);
        PG8_WAIT_V(6); PG8_BAR;
    } else {
        PG8_STAGE(PG8_SB(0, 0), cB, voffB); PG8_STAGE(PG8_SA(0, 0), cA, voffA); PG8_STAGE(PG8_SB(0, 1), cB + hstep, voffB); PG8_STAGE(PG8_SA(0, 1), cA + hstep, voffA);
        if (wr == 1) PG8_BAR;
        PG8_WAIT_V(4); PG8_BAR;
        PG8_STAGE(PG8_SB(1, 0), cB + kstep, voffB); PG8_STAGE(PG8_SA(1, 0), cA + kstep, voffA); PG8_STAGE(PG8_SB(1, 1), cB + hstep + kstep, voffB);
        PG8_WAIT_V(6); PG8_BAR;
    }
    for (;;) {
        const bool has_next = S.next(ui + 1, nxt);
        const char* nA = has_next ? (const char*)g.A + S.abase(nxt, K) : cA; const char* nB = has_next ? (const char*)g.Bt + (size_t)nxt.pn * tstep : cB;
        for (int t = 0; t < nt; t += 2) {
            const bool last = (t == nt - 2);
            const char* a1 = cA + (size_t)(t + 1) * kstep;
            const char* a2 = last ? nA : cA + (size_t)(t + 2) * kstep; const char* b2 = last ? nB : cB + (size_t)(t + 2) * kstep;
            const char* a3 = a2 + kstep; const char* b3 = b2 + kstep;
            if (last && has_next) S.a_ready(nxt);
            if constexpr (SP2) {
            PG8_LDB(B0, 0, 0); PG8_LDB(B1, 0, 1); PG8_SCHED; PG8_LDA(At, 0, 0); PG8_STAGE(PG8_SA(1, 1), a1 + hstep, voffA);
            PG8_WAIT_V(8); PG8_WAIT_L(0); PG8_BAR; PG8_MMA(0, 0, At, B0); PG8_MMA(0, 1, At, B1); PG8_BAR; PG8_SCHED;
            PG8_LDA(At, 0, 1); PG8_STAGE(PG8_SB(0, 0), b2, voffB); PG8_STAGE(PG8_SB(0, 1), b2 + hstep, voffB); PG8_STAGE(PG8_SA(0, 0), a2, voffA);
            PG8_WAIT_V(8); PG8_WAIT_L(0); PG8_BAR; PG8_MMA(1, 0, At, B0); PG8_MMA(1, 1, At, B1); PG8_BAR; PG8_SCHED;
            PG8_LDB(B0, 1, 0); PG8_LDB(B1, 1, 1); PG8_SCHED; PG8_LDA(At, 1, 0); PG8_STAGE(PG8_SA(0, 1), a2 + hstep, voffA);
            PG8_WAIT_V(8); PG8_WAIT_L(0); PG8_BAR; PG8_MMA(0, 0, At, B0); PG8_MMA(0, 1, At, B1); PG8_BAR; PG8_SCHED;
            PG8_LDA(At, 1, 1); PG8_STAGE(PG8_SB(1, 0), b3, voffB); PG8_STAGE(PG8_SB(1, 1), b3 + hstep, voffB); PG8_STAGE(PG8_SA(1, 0), a3, voffA);
            PG8_WAIT_V(8); PG8_WAIT_L(0); PG8_BAR; PG8_MMA(1, 0, At, B0); PG8_MMA(1, 1, At, B1); PG8_BAR; PG8_SCHED;
            } else {
            PG8_LDB(B0, 0, 0); PG8_SCHED; PG8_LDA(At, 0, 0); PG8_STAGE(PG8_SA(1, 1), a1 + hstep, voffA);
            PG8_WAIT_L(8); PG8_BAR; PG8_WAIT_L(0); PG8_MMA(0, 0, At, B0); PG8_BAR; PG8_SCHED;
            PG8_LDB(B1, 0, 1); PG8_STAGE(PG8_SB(0, 0), b2, voffB);
            PG8_BAR; PG8_WAIT_L(0); PG8_MMA(0, 1, At, B1); PG8_BAR;
            PG8_LDA(At, 0, 1); PG8_STAGE(PG8_SA(0, 0), a2, voffA);
            PG8_BAR; PG8_WAIT_L(0); PG8_MMA(1, 0, At, B0); PG8_BAR; PG8_SCHED;
            PG8_STAGE(PG8_SB(0, 1), b2 + hstep, voffB);
            PG8_WAIT_V(6); PG8_BAR; PG8_MMA(1, 1, At, B1); PG8_BAR;
            PG8_LDB(B0, 1, 0); PG8_SCHED; PG8_LDA(At, 1, 0); PG8_STAGE(PG8_SA(0, 1), a2 + hstep, voffA);
            PG8_WAIT_L(8); PG8_BAR; PG8_WAIT_L(0); PG8_MMA(0, 0, At, B0); PG8_BAR; PG8_SCHED;
            PG8_LDB(B1, 1, 1); PG8_STAGE(PG8_SB(1, 0), b3, voffB);
            PG8_BAR; PG8_WAIT_L(0); PG8_MMA(0, 1, At, B1); PG8_BAR;
            PG8_LDA(At, 1, 1); PG8_STAGE(PG8_SA(1, 0), a3, voffA);
            PG8_BAR; PG8_WAIT_L(0); PG8_MMA(1, 0, At, B0); PG8_BAR; PG8_SCHED;
            PG8_STAGE(PG8_SB(1, 1), b3 + hstep, voffB);
            PG8_WAIT_V(6); PG8_BAR; PG8_MMA(1, 1, At, B1); PG8_BAR;
            }
        }
        if constexpr (ALIGN_EPI) { if (wr == 0) PG8_BAR; }
        if constexpr (!Epi::AFTER_DRAIN) { E(acc, cur, wr, wc, fr, fq); S.done(cur); }
        if (!has_next) break;
#pragma unroll
        for (int a = 0; a < 2; ++a)
#pragma unroll
            for (int b = 0; b < 2; ++b)
#pragma unroll
                for (int m = 0; m < 4; ++m)
#pragma unroll
                    for (int n = 0; n < 2; ++n) acc[a][b][m][n] = (f32x4){0.f, 0.f, 0.f, 0.f};
        cur = nxt; cA = nA; cB = nB; ++ui;
        if constexpr (ALIGN_EPI) { if (wr == 1) PG8_BAR; }
    }
    PG8_WAIT_V(0);
    if constexpr (!ALIGN_EPI) { if (wr == 0) PG8_BAR; }
    PG8_BAR;
    if constexpr (Epi::AFTER_DRAIN) { E.fused(acc, cur, wr, wc, fr, fq, lds, wid, lane); S.done(cur); }
#undef PG8_SA
#undef PG8_SB
#undef PG8_STAGE
#undef PG8_LDA
#undef PG8_LDB
#undef PG8_MMA
#undef PG8_WAIT_V
#undef PG8_WAIT_L
#undef PG8_BAR
#undef PG8_SCHED
}

}

using pg8::bf16_t; using pg8::bf16x8; using pg8::f32x4; using pg8::u32x4; using pg8::Unit;
typedef float f32x16 __attribute__((ext_vector_type(16)));
typedef short s16x4 __attribute__((ext_vector_type(4)));
typedef unsigned u32x2 __attribute__((ext_vector_type(2)));

constexpr int MT = 32768, NPR = 16384, DM = 1024, DFF = 2816, NIN = 1056;
constexpr float EPS = 1e-6f;
constexpr float QSCALE = 0.10206207261596575f * 1.4426950408889634f;
constexpr size_t MiB = 1048576;
constexpr size_t W_BT1 = 0, W_BT2Q = W_BT1 + 1792 * 1024 * 2, W_BT2KV = W_BT2Q + 768 * 256 * 2, W_BTOUT = W_BT2KV + 1024 * 256 * 2, W_BTG = W_BTOUT + 1024 * 1024 * 2,
                 W_BTU = W_BTG + (size_t)DFF * 1024 * 2, W_BTD = W_BTU + (size_t)DFF * 1024 * 2, W_F1 = W_BTD + (size_t)DFF * 1024 * 2, W_F2A = W_F1 + 128 * 128 * 2, W_F2B = W_F2A + 128 * 256 * 2,
                 W_RCOS = W_F2B + 64 * 128 * 2, W_RSIN = W_RCOS + 8192 * 16 * 4, W_TW = W_RSIN + 8192 * 16 * 4, W_RX = W_TW + 8192 * 8, W_R2 = W_RX + MT * 4, W_SSP = W_R2 + MT * 4,
                 W_SS2 = W_SSP + (size_t)MT * 8 * 4, W_SS3 = W_SS2 + (size_t)MT * 16 * 4, W_KRP = W_SS3 + (size_t)MT * 16 * 4, W_BAR = W_KRP + (size_t)MT * 32 * 2, W_TS = W_BAR + 16384, W_SMALL_END = W_TS + 256;
static_assert(W_SMALL_END <= 32 * MiB, "small region");
constexpr size_t W_XB = 32 * MiB  , W_MIX = 96 * MiB  , W_CQ = W_MIX, W_CKV = W_MIX + 16 * MiB, W_ACT = 160 * MiB  , W_VC = W_ACT, W_AF = W_ACT,
                 W_END = 248 * MiB;
constexpr size_t O_Q = 0, O_KN = 48 * MiB, O_VV = 80 * MiB, O_ACT1 = 0;
#ifndef GEMM_ALIGN
#define GEMM_ALIGN true
#endif
#ifndef GEMM_SP2
#define GEMM_SP2 true
#endif
constexpr int LDS_X = 131072 + 64, LDS_BYTES = LDS_X + 2048;

#ifndef DIAG_A
#define DIAG_A -1
#define DIAG_B 0
#define DIAG_C 0
#define DIAG_D 0
#endif
struct Params { const float* in[18]; float* out; unsigned char* ws; };
typedef const __attribute__((address_space(4))) Params* KP;
#define KP_OPAQUE(p) asm volatile("" : "+s"(p))

typedef __bf16 bf16x2_t __attribute__((ext_vector_type(2)));
typedef float f32x2_t __attribute__((ext_vector_type(2)));
__device__ __forceinline__ unsigned cvtpk(float lo, float hi) { f32x2_t v = {lo, hi}; bf16x2_t b = __builtin_convertvector(v, bf16x2_t); return __builtin_bit_cast(unsigned, b); }
__device__ __forceinline__ bf16_t f2bf(float f) { return (bf16_t)(cvtpk(f, 0.f) & 0xffffu); }
__device__ __forceinline__ u32x4 pack8(f32x4 a, f32x4 b) { u32x4 w; w.x = cvtpk(a[0], a[1]); w.y = cvtpk(a[2], a[3]); w.z = cvtpk(b[0], b[1]); w.w = cvtpk(b[2], b[3]); return w; }
__device__ __forceinline__ float bflo(unsigned u) { return __uint_as_float(u << 16); }
__device__ __forceinline__ float bfhi(unsigned u) { return __uint_as_float(u & 0xffff0000u); }
__device__ __forceinline__ void unpack8(u32x4 w, f32x4& a, f32x4& b) { a = (f32x4){bflo(w.x), bfhi(w.x), bflo(w.y), bfhi(w.y)}; b = (f32x4){bflo(w.z), bfhi(w.z), bflo(w.w), bfhi(w.w)}; }
__device__ __forceinline__ int tok_pos(int row) { return row < NPR ? (row & 8191) : (row & 4095); }
__device__ __forceinline__ int tok_len(int row) { return row < NPR ? 8192 : 4096; }
__device__ __forceinline__ float wave_sum(float v) { for (int o = 32; o >= 1; o >>= 1) v += __shfl_xor(v, o); return v; }

#define EPI_ARGS const f32x4 (&acc)[2][2][4][2], const Unit& u, int wr, int wc, int fr_, int fq_
#define EPI_LOCALS int t_ = threadIdx.x; asm volatile("" : "+v"(t_)); const int fr = t_ & 15, fq = (t_ >> 4) & 3;
struct Epi1 {
    static constexpr bool PERM = true, AFTER_DRAIN = false;
    const float* RX; bf16_t* CQ; bf16_t* CKV; float* SSP; bf16_t* VC; bf16_t* KRP; const float* RCOS; const float* RSIN;
    __device__ __forceinline__ void operator()(EPI_ARGS) const {
        EPI_LOCALS
        const int row0 = u.pm * 256 + wr * 64 + fr, colt = wc * 32 + 8 * fq; float rxv[2][4];
#pragma unroll
        for (int ai = 0; ai < 2; ++ai)
#pragma unroll
            for (int m = 0; m < 4; ++m) rxv[ai][m] = RX[row0 + ai * 128 + m * 16];
        if (u.pn < 2) {
            bf16_t* dst = u.pn == 0 ? CQ : CKV;
#pragma unroll
            for (int ai = 0; ai < 2; ++ai)
#pragma unroll
                for (int m = 0; m < 4; ++m) { const int row = row0 + ai * 128 + m * 16; const float rx = rxv[ai][m]; float ss = 0.f;
#pragma unroll
                    for (int bj = 0; bj < 2; ++bj) { const f32x4 v0 = acc[ai][bj][m][0] * rx, v1 = acc[ai][bj][m][1] * rx;
                        ss += (v0[0] * v0[0] + v0[1] * v0[1]) + (v0[2] * v0[2] + v0[3] * v0[3]) + (v1[0] * v1[0] + v1[1] * v1[1]) + (v1[2] * v1[2] + v1[3] * v1[3]);
                        *(u32x4*)(dst + (unsigned)(row * 256 + bj * 128 + colt)) = pack8(v0, v1); }
                    ss += __shfl_xor(ss, 16); ss += __shfl_xor(ss, 32);
                    if (fq == 0) SSP[(unsigned)(row * 8 + u.pn * 4 + wc)] = ss; }
        } else if (u.pn < 6) {
#pragma unroll
            for (int ai = 0; ai < 2; ++ai)
#pragma unroll
                for (int m = 0; m < 4; ++m) { const int row = row0 + ai * 128 + m * 16; const float rx = rxv[ai][m];
#pragma unroll
                    for (int bj = 0; bj < 2; ++bj) *(u32x4*)(VC + (unsigned)(row * 1024 + (u.pn - 2) * 256 + bj * 128 + colt)) = pack8(acc[ai][bj][m][0] * rx, acc[ai][bj][m][1] * rx); }
        } else if (wc == 0) {
#pragma unroll
            for (int ai = 0; ai < 2; ++ai)
#pragma unroll
                for (int m = 0; m < 4; ++m) { const int row = row0 + ai * 128 + m * 16; const float rx = rxv[ai][m]; const int pos = tok_pos(row);
                    const f32x4 c4 = *(const f32x4*)(RCOS + pos * 16 + 4 * fq), s4 = *(const f32x4*)(RSIN + pos * 16 + 4 * fq);
                    const f32x4 x1 = acc[ai][0][m][0] * rx, x2 = acc[ai][0][m][1] * rx;
                    *(u32x4*)(KRP + (unsigned)(row * 32 + 8 * fq)) = pack8(x1 * c4 - x2 * s4, x2 * c4 + x1 * s4); }
        }
    }
};
struct Epi2Q {
    static constexpr bool PERM = true, AFTER_DRAIN = false;
    const float* SSP; bf16_t* Q;
    __device__ __forceinline__ void operator()(EPI_ARGS) const {
        EPI_LOCALS
        const int row0 = u.pm * 256 + wr * 64 + fr;
        const int G0 = 32 * u.pn + 4 * wc + fq, h0 = G0 / 12, p0 = G0 - 12 * h0, G1 = G0 + 16, h1 = G1 / 12, p1 = G1 - 12 * h1;
        const unsigned base0 = (unsigned)(h0 * MT * 96 + 8 * p0), base1 = (unsigned)(h1 * MT * 96 + 8 * p1);
#pragma unroll
        for (int ai = 0; ai < 2; ++ai) { float rq[4];
#pragma unroll
            for (int m = 0; m < 4; ++m) { const f32x4 sp = *(const f32x4*)(SSP + (unsigned)((row0 + ai * 128 + m * 16) * 8)); rq[m] = rsqrtf(((sp[0] + sp[1]) + (sp[2] + sp[3])) * (1.0f / 256.0f) + EPS); }
#pragma unroll
            for (int m = 0; m < 4; ++m) { const unsigned ro = (unsigned)((row0 + ai * 128 + m * 16) * 96);
                *(u32x4*)(Q + base0 + ro) = pack8(acc[ai][0][m][0] * rq[m], acc[ai][0][m][1] * rq[m]);
                *(u32x4*)(Q + base1 + ro) = pack8(acc[ai][1][m][0] * rq[m], acc[ai][1][m][1] * rq[m]); }
            asm volatile("" ::: "memory"); }
    }
};
struct Epi2KV {
    static constexpr bool PERM = true, AFTER_DRAIN = false;
    const float* SSP; bf16_t* KN; bf16_t* VV;
    __device__ __forceinline__ void operator()(EPI_ARGS) const {
        EPI_LOCALS
        const int row0 = u.pm * 256 + wr * 64 + fr; const int within = (wc & 1) * 32 + 8 * fq; bf16_t* dst = wc < 2 ? KN : VV; float rk[2][4];
#pragma unroll
        for (int ai = 0; ai < 2; ++ai)
#pragma unroll
            for (int m = 0; m < 4; ++m) { const f32x4 sp = *(const f32x4*)(SSP + (unsigned)((row0 + ai * 128 + m * 16) * 8 + 4)); rk[ai][m] = rsqrtf(((sp[0] + sp[1]) + (sp[2] + sp[3])) * (1.0f / 256.0f) + EPS); }
#pragma unroll
        for (int ai = 0; ai < 2; ++ai)
#pragma unroll
            for (int m = 0; m < 4; ++m) { const int row = row0 + ai * 128 + m * 16;
#pragma unroll
                for (int bj = 0; bj < 2; ++bj) { const int head = 2 * u.pn + bj;
                    *(u32x4*)(dst + (unsigned)((head * MT + row) * 64 + within)) = pack8(acc[ai][bj][m][0] * rk[ai][m], acc[ai][bj][m][1] * rk[ai][m]); } }
    }
};
struct EpiSS {
    static constexpr bool PERM = true, AFTER_DRAIN = false;
    bf16_t* O; float* SS;
    __device__ __forceinline__ void operator()(EPI_ARGS) const {
        EPI_LOCALS
        const int row0 = u.pm * 256 + wr * 64 + fr, colt = u.pn * 256 + wc * 32 + 8 * fq;
#pragma unroll
        for (int ai = 0; ai < 2; ++ai)
#pragma unroll
            for (int m = 0; m < 4; ++m) { const int row = row0 + ai * 128 + m * 16; float ss = 0.f;
#pragma unroll
                for (int bj = 0; bj < 2; ++bj) { const f32x4 v0 = acc[ai][bj][m][0], v1 = acc[ai][bj][m][1];
                    ss += (v0[0] * v0[0] + v0[1] * v0[1]) + (v0[2] * v0[2] + v0[3] * v0[3]) + (v1[0] * v1[0] + v1[1] * v1[1]) + (v1[2] * v1[2] + v1[3] * v1[3]);
                    *(u32x4*)(O + (unsigned)(row * 1024 + bj * 128 + colt)) = pack8(v0, v1); }
                ss += __shfl_xor(ss, 16); ss += __shfl_xor(ss, 32);
                if (fq == 0) SS[(unsigned)(row * 16 + u.pn * 4 + wc)] = ss; }
    }
};
struct EpiGate {
    static constexpr bool PERM = true, AFTER_DRAIN = false;
    const float* R2; bf16_t* G;
    __device__ __forceinline__ void operator()(EPI_ARGS) const {
        EPI_LOCALS
        const int row0 = u.pm * 256 + wr * 64 + fr, colt = u.pn * 256 + wc * 32 + 8 * fq;
#pragma unroll
        for (int ai = 0; ai < 2; ++ai)
#pragma unroll
            for (int m = 0; m < 4; ++m) { const int row = row0 + ai * 128 + m * 16; const float r2 = R2[row];
#pragma unroll
                for (int bj = 0; bj < 2; ++bj) *(u32x4*)(G + (unsigned)(row * DFF + bj * 128 + colt)) = pack8(acc[ai][bj][m][0] * r2, acc[ai][bj][m][1] * r2); }
    }
};
__device__ __forceinline__ float gelu_t(float x) {
    const float u2 = x * (1.5957691216057308f + 0.07135481627159855f * x * x);
    return x * __builtin_amdgcn_rcpf(1.0f + __builtin_amdgcn_exp2f(-1.4426950408889634f * u2));
}
__device__ __forceinline__ f32x4 gelu_mul4(f32x4 x, f32x4 y) {
    const f32x4 t = x * (x * x * (-0.10294324283f) + (-2.3022081910f));
    f32x4 e; e[0] = __builtin_amdgcn_exp2f(t[0]); e[1] = __builtin_amdgcn_exp2f(t[1]); e[2] = __builtin_amdgcn_exp2f(t[2]); e[3] = __builtin_amdgcn_exp2f(t[3]);
    const f32x4 d = e + 1.0f; f32x4 r; r[0] = __builtin_amdgcn_rcpf(d[0]); r[1] = __builtin_amdgcn_rcpf(d[1]); r[2] = __builtin_amdgcn_rcpf(d[2]); r[3] = __builtin_amdgcn_rcpf(d[3]);
    return (x * y) * r;
}
template <int CTRL> __device__ __forceinline__ u32x4 dppv(u32x4 old, u32x4 src) {
    u32x4 r; r.x = (unsigned)__builtin_amdgcn_update_dpp((int)old.x, (int)src.x, CTRL, 0xf, 0xf, false); r.y = (unsigned)__builtin_amdgcn_update_dpp((int)old.y, (int)src.y, CTRL, 0xf, 0xf, false);
    r.z = (unsigned)__builtin_amdgcn_update_dpp((int)old.z, (int)src.z, CTRL, 0xf, 0xf, false); r.w = (unsigned)__builtin_amdgcn_update_dpp((int)old.w, (int)src.w, CTRL, 0xf, 0xf, false); return r; }
struct EpiUp {
    static constexpr bool PERM = true, AFTER_DRAIN = false;
    const float* R2; const bf16_t* G; const float* CW; const float* CB; bf16_t* ACT; int hb;
    __device__ __forceinline__ void operator()(EPI_ARGS) const {
        EPI_LOCALS
        const int row0 = u.pm * 256 + wr * 64 + fr;
#pragma unroll
        for (int bj = 0; bj < 2; ++bj) { const int col = u.pn * 256 + bj * 128 + wc * 32 + 8 * fq;
            const f32x4 w0a = *(const f32x4*)(CW + col), w0b = *(const f32x4*)(CW + col + 4), w1a = *(const f32x4*)(CW + DFF + col), w1b = *(const f32x4*)(CW + DFF + col + 4),
                        w2a = *(const f32x4*)(CW + 2 * DFF + col), w2b = *(const f32x4*)(CW + 2 * DFF + col + 4), ba = *(const f32x4*)(CB + col), bb = *(const f32x4*)(CB + col + 4);
#pragma unroll
            for (int ai = 0; ai < 2; ++ai) { const int rA = row0 + ai * 128, rZ = rA + 48; const bf16_t* gp = G + (unsigned)(rA * DFF + col);
                u32x4 cen[4], pb = {0u, 0u, 0u, 0u}, nb = {0u, 0u, 0u, 0u}; float r2v[4];
#pragma unroll
                for (int m = 0; m < 4; ++m) { cen[m] = *(const u32x4*)(gp + m * 16 * DFF); r2v[m] = R2[rA + m * 16]; }
                if (fr == 0 && tok_pos(hb + rA) > 0) pb = *(const u32x4*)(gp - DFF);
                if (fr == 15 && tok_pos(hb + rZ) < tok_len(hb + rZ) - 1) nb = *(const u32x4*)(gp + 49 * DFF);
#pragma unroll
                for (int m = 0; m < 4; ++m) { const int row = rA + m * 16;
                    const u32x4 tp = (m == 0) ? pb : dppv<0x121>(cen[m == 0 ? 0 : m - 1], cen[m == 0 ? 0 : m - 1]);
                    const u32x4 tn = (m == 3) ? nb : dppv<0x12F>(cen[m == 3 ? 3 : m + 1], cen[m == 3 ? 3 : m + 1]);
                    const u32x4 w0 = dppv<0x111>(tp, cen[m]), w2 = dppv<0x101>(tn, cen[m]);
                    f32x4 g0a, g0b, g1a, g1b, g2a, g2b; unpack8(w0, g0a, g0b); unpack8(cen[m], g1a, g1b); unpack8(w2, g2a, g2b);
                    const f32x4 ta = ba + w0a * g0a + w1a * g1a + w2a * g2a, tb = bb + w0b * g0b + w1b * g1b + w2b * g2b;
                    const f32x4 ua = acc[ai][bj][m][0] * r2v[m], ub = acc[ai][bj][m][1] * r2v[m];
                    f32x4 oa, ob;
#pragma unroll
                    for (int j = 0; j < 4; ++j) { oa[j] = gelu_t(ta[j]) * ua[j]; ob[j] = gelu_t(tb[j]) * ub[j]; }
                    *(u32x4*)(ACT + (unsigned)(row * DFF + col)) = pack8(oa, ob); }
                asm volatile("" ::: "memory"); } }
    }
};

struct EpiGU {
    static constexpr bool PERM = true, AFTER_DRAIN = false;
    const float* R2; const float* CW; const float* CB; bf16_t* ACT; PG8_LAS unsigned* X; int hb, slen, nT;
    __device__ __forceinline__ void operator()(EPI_ARGS) const {
        EPI_LOCALS
        const int sq = u.pm / nT, tt = u.pm - sq * nT, rb = sq * slen + 254 * tt - 1;
        const int col = u.pn * 128 + wc * 32 + 8 * fq, li0 = wr * 64 + fr;
        float r2v[2][4];
#pragma unroll
        for (int ai = 0; ai < 2; ++ai)
#pragma unroll
            for (int m = 0; m < 4; ++m) { int gr = hb + rb + ai * 128 + li0 + m * 16; gr = gr < 0 ? 0 : (gr > MT - 1 ? MT - 1 : gr); r2v[ai][m] = R2[gr]; }
        const f32x4 w0a = *(const f32x4*)(CW + col), w0b = *(const f32x4*)(CW + col + 4), w1a = *(const f32x4*)(CW + DFF + col), w1b = *(const f32x4*)(CW + DFF + col + 4),
                    w2a = *(const f32x4*)(CW + 2 * DFF + col), w2b = *(const f32x4*)(CW + 2 * DFF + col + 4), ba = *(const f32x4*)(CB + col), bb = *(const f32x4*)(CB + col + 4);
#pragma unroll
        for (int ai = 0; ai < 2; ++ai) { PG8_LAS unsigned* xs = X + (((wr * 4 + wc) * 2 + ai) * 2) * 16 + fq * 4;
            if (fr == 0) *(PG8_LAS u32x4*)xs = pack8(acc[ai][0][0][0] * r2v[ai][0], acc[ai][0][0][1] * r2v[ai][0]);
            if (fr == 15) *(PG8_LAS u32x4*)(xs + 16) = pack8(acc[ai][0][3][0] * r2v[ai][3], acc[ai][0][3][1] * r2v[ai][3]); }
        asm volatile("s_waitcnt lgkmcnt(0)" ::: "memory"); __builtin_amdgcn_s_barrier(); if (!GEMM_ALIGN && wr == 0) __builtin_amdgcn_s_barrier(); asm volatile("" ::: "memory");
        const int pw = wr ^ 1;
#pragma unroll
        for (int ai = 0; ai < 2; ++ai) {
            const int pai = wr ? ai : ai - 1, nai = wr ? ai + 1 : ai;
            u32x4 pb = {0u, 0u, 0u, 0u}, nb = {0u, 0u, 0u, 0u};
            if (pai >= 0) pb = *(const PG8_LAS u32x4*)(X + (((pw * 4 + wc) * 2 + pai) * 2 + 1) * 16 + fq * 4);
            if (nai <= 1) nb = *(const PG8_LAS u32x4*)(X + (((pw * 4 + wc) * 2 + nai) * 2 + 0) * 16 + fq * 4);
            u32x4 cen[4];
#pragma unroll
            for (int m = 0; m < 4; ++m) cen[m] = pack8(acc[ai][0][m][0] * r2v[ai][m], acc[ai][0][m][1] * r2v[ai][m]);
#pragma unroll
            for (int m = 0; m < 4; ++m) { const int li = ai * 128 + li0 + m * 16, row = rb + li, pos = row - sq * slen;
                const u32x4 tp = (m == 0) ? pb : dppv<0x121>(cen[m == 0 ? 0 : m - 1], cen[m == 0 ? 0 : m - 1]);
                const u32x4 tn = (m == 3) ? nb : dppv<0x12F>(cen[m == 3 ? 3 : m + 1], cen[m == 3 ? 3 : m + 1]);
                u32x4 w0 = dppv<0x111>(tp, cen[m]), w2 = dppv<0x101>(tn, cen[m]);
                if (pos == 0) w0 = (u32x4){0u, 0u, 0u, 0u};
                if (pos == slen - 1) w2 = (u32x4){0u, 0u, 0u, 0u};
                f32x4 g0a, g0b, g1a, g1b, g2a, g2b; unpack8(w0, g0a, g0b); unpack8(cen[m], g1a, g1b); unpack8(w2, g2a, g2b);
                const f32x4 ta = ba + w0a * g0a + w1a * g1a + w2a * g2a, tb = bb + w0b * g0b + w1b * g1b + w2b * g2b;
                const f32x4 ua = acc[ai][1][m][0] * r2v[ai][m], ub = acc[ai][1][m][1] * r2v[ai][m];
                const f32x4 oa = gelu_mul4(ta, ua), ob = gelu_mul4(tb, ub);
                if (li >= 1 && li <= 254 && pos >= 0 && pos < slen) *(u32x4*)(ACT + (unsigned)(row * DFF + col)) = pack8(oa, ob); }
            asm volatile("" ::: "memory"); }
        if (!GEMM_ALIGN && wr == 1) { asm volatile("s_waitcnt lgkmcnt(0)" ::: "memory"); __builtin_amdgcn_s_barrier(); }
    }
};

template <class F> __device__ __forceinline__ void ttile(const F& src, bf16_t* dst, int lddst, int k0, int n0, float* tile) {
    const int tid = threadIdx.x, a = tid >> 6, b = tid & 63;
#pragma unroll
    for (int i = 0; i < 8; ++i) { const int kk = a + 8 * i; tile[kk * 65 + b] = src(k0 + kk, n0 + b); }
    __syncthreads();
    const int a2 = tid >> 5, b2 = (tid & 31) * 2;
#pragma unroll
    for (int i = 0; i < 4; ++i) { const int nn = a2 + 16 * i; *(unsigned*)(dst + (size_t)(n0 + nn) * lddst + k0 + b2) = cvtpk(tile[b2 * 65 + nn], tile[(b2 + 1) * 65 + nn]); }
    __syncthreads();
}
__device__ __forceinline__ void ttile128(const float* w, int ld, const float* g, bf16_t* dst, int lddst, int k0, int n0, int dstrow0, float* tile, int tid) {
#pragma unroll
    for (int i = 0; i < 8; ++i) { const int idx = tid + 512 * i, kk = idx >> 5, n4 = (idx & 31) * 4;
        f32x4 v = *(const f32x4*)(w + (size_t)(k0 + kk) * ld + n0 + n4); if (g) v = v * g[k0 + kk];
        float* t = tile + kk * 129 + n4; t[0] = v[0]; t[1] = v[1]; t[2] = v[2]; t[3] = v[3]; }
    __syncthreads();
#pragma unroll
    for (int i = 0; i < 4; ++i) { const int idx = tid + 512 * i, nn = idx >> 4, k8 = (idx & 15) * 8; const float* t = tile + k8 * 129 + nn;
        u32x4 o; o.x = cvtpk(t[0], t[129]); o.y = cvtpk(t[2 * 129], t[3 * 129]); o.z = cvtpk(t[4 * 129], t[5 * 129]); o.w = cvtpk(t[6 * 129], t[7 * 129]);
        *(u32x4*)(dst + (size_t)(dstrow0 + nn) * lddst + k0 + k8) = o; }
    __syncthreads();
}
struct SrcPlain { const float* w; int ld; const float* g; float mul; __device__ __forceinline__ float operator()(int k, int n) const { return w[(size_t)k * ld + n] * (g ? g[k] : 1.0f) * mul; } };
struct SrcQ { const float* w; const float* g; __device__ __forceinline__ float operator()(int k, int n) const {
    const int G = n >> 3, i8 = n & 7, head = G / 12, part = G - 12 * head; int oc;
    if (part < 8) oc = head * 96 + 8 * part + i8; else { const int i = part - 8; oc = head * 96 + 64 + (i8 < 4 ? 4 * i + i8 : 16 + 4 * i + (i8 - 4)); }
    return w[(size_t)k * 768 + oc] * g[k] * QSCALE; } };
struct SrcKR { const float* w; const float* g; __device__ __forceinline__ float operator()(int k, int p) const {
    if (p >= 32) return 0.f; const int oc = 512 + ((p >> 2) & 1) * 16 + 4 * (p >> 3) + (p & 3); return w[(size_t)k * NIN + oc] * g[k]; } };
struct SrcV { const float* w; const float* g; const float* cs; __device__ __forceinline__ float operator()(int k, int n) const {
    const int chp = n >> 1, reim = n & 1, grp = chp >> 7, cp = chp & 127; const float* wr = w + (size_t)k * NIN + 544 + grp * 128; float s = 0.f;
    for (int c = 0; c < 128; ++c) s += wr[c] * cs[2 * ((c * cp) & 127) + reim];
    return s * g[k] * 0.08838834764831845f; } };
struct SrcFO { const float* wf; const float* wo; __device__ __forceinline__ float operator()(int k, int n) const {
    const int kk = k - 512, grp = kk >> 7; const float* a = wf + (size_t)kk * 128; const float* b = wo + (size_t)(512 + grp * 128) * 1024 + n; float s = 0.f;
    for (int c2 = 0; c2 < 128; ++c2) s += a[c2] * b[(size_t)c2 * 1024];
    return s; } };

template <int UF, class FA, class FB> __device__ __forceinline__ void tile_mm(const FA& fa, const FB& fb, bf16_t* dst, int lddst, int k0, int n0, float* tile, float* As, float* Bs, int tid) {
    const int a = tid >> 6, b = tid & 63;
#pragma unroll UF
    for (int i = 0; i < 16; ++i) { const int idx = tid + 512 * i; As[(idx >> 7) * 132 + (idx & 127)] = fa(idx >> 7, idx & 127); }
#pragma unroll UF
    for (int i = 0; i < 16; ++i) { const int idx = tid + 512 * i; Bs[idx] = fb(idx >> 6, idx & 63); }
    __syncthreads();
    { const int wv = tid >> 6, ln = tid & 63, l32 = ln & 31, hi = ln >> 5;
      if (wv < 4) { const int mb = wv >> 1, nb = wv & 1; f32x16 acc = {};
#pragma unroll 8
          for (int s2 = 0; s2 < 64; ++s2) { const int c = 2 * s2 + hi; acc = __builtin_amdgcn_mfma_f32_32x32x2f32(As[(32 * mb + l32) * 132 + c], Bs[c * 64 + 32 * nb + l32], acc, 0, 0, 0); }
#pragma unroll
          for (int r = 0; r < 16; ++r) tile[(32 * mb + (r & 3) + 8 * (r >> 2) + 4 * hi) * 65 + 32 * nb + l32] = acc[r]; } }
    __syncthreads();
    const int a2 = tid >> 5, b2_ = (tid & 31) * 2;
#pragma unroll
    for (int i = 0; i < 4; ++i) { const int nn = a2 + 16 * i; *(unsigned*)(dst + (size_t)(n0 + nn) * lddst + k0 + b2_) = cvtpk(tile[b2_ * 65 + nn], tile[(b2_ + 1) * 65 + nn]); }
    __syncthreads();
}
struct MmVA { const float* w; const float* g; int k0, grp; __device__ __forceinline__ float operator()(int kk, int c) const { return w[(size_t)(k0 + kk) * NIN + 544 + grp * 128 + c] * g[k0 + kk] * 0.08838834764831845f; } };
struct MmVB { const float* cs; int n0; __device__ __forceinline__ float operator()(int c, int nn) const { const int n = n0 + nn, cp = (n >> 1) & 127; return cs[2 * ((c * cp) & 127) + (n & 1)]; } };
struct MmFA { const float* wf; int kb; __device__ __forceinline__ float operator()(int kk, int c2) const { return wf[(size_t)(kb + kk) * 128 + c2]; } };
struct MmFB { const float* wo; int grp, n0; __device__ __forceinline__ float operator()(int c2, int nn) const { return wo[(size_t)(512 + grp * 128 + c2) * 1024 + n0 + nn]; } };

__device__ __forceinline__ void phase0(KP p, unsigned char* shm) {
    int tid_ = threadIdx.x; asm volatile("" : "+v"(tid_));
    const int tid = tid_, lane = tid & 63, wid = tid >> 6, G = gridDim.x, b = blockIdx.x;
    unsigned char* ws = p->ws;
    float* tile = (float*)shm; float* cs = (float*)(shm + 102400); float* As = (float*)(shm + 32768); float* Bs = (float*)(shm + 32768 + 64 * 132 * 4);
    if (tid < 128) { float s, c; sincospif((float)tid * (1.0f / 64.0f), &s, &c); cs[2 * tid] = c; cs[2 * tid + 1] = -s; }
    __syncthreads();
    const float *x_in = p->in[2]  , *w_in = p->in[3], *g_q = p->in[4], *w_uq = p->in[5], *g_kv = p->in[6], *w_ukv = p->in[7], *w_fnet = p->in[8], *w_out = p->in[9],
                *g_pre_ffn = p->in[11], *w_gate = p->in[12], *w_up = p->in[13], *w_down = p->in[16];
    bf16_t *BT1 = (bf16_t*)(ws + W_BT1), *BT2Q = (bf16_t*)(ws + W_BT2Q), *BT2KV = (bf16_t*)(ws + W_BT2KV), *BTOUT = (bf16_t*)(ws + W_BTOUT), *BTG = (bf16_t*)(ws + W_BTG), *BTU = (bf16_t*)(ws + W_BTU), *BTD = (bf16_t*)(ws + W_BTD);
    constexpr int J0 = 256, J1 = J0  , J2 = J1 + 32, J3 = J2 + 16, J4 = J3 + 32, J5 = J4 + 176, J6 = J5 + 176, J7 = J6 + 176, J8 = J7 + 48, J9 = J8 + 64;
    bf16_t* XB = (bf16_t*)(ws + W_XB); float* RX = (float*)(ws + W_RX);
    int rowA = b * 8 + wid; f32x4 rv[2][4]; int rrow[2] = {0, 0};
#define ROWS_LOAD() do { rrow[0] = rowA; rrow[1] = rowA + G * 8 < MT ? rowA + G * 8 : rowA; _Pragma("unroll") for (int q = 0; q < 2; ++q) { \
        const float* xr = rrow[q] < NPR ? p->in[0] + (size_t)rrow[q] * DM : p->in[1] + (size_t)(rrow[q] - NPR) * DM; _Pragma("unroll") for (int j = 0; j < 4; ++j) rv[q][j] = __builtin_nontemporal_load((const f32x4*)(xr + j * 256 + lane * 4)); } } while (0)
#define ROWS_FINISH() do { _Pragma("unroll") for (int q = 0; q < 2; ++q) { float ss = 0.f; \
        _Pragma("unroll") for (int j = 0; j < 4; ++j) ss += (rv[q][j][0] * rv[q][j][0] + rv[q][j][1] * rv[q][j][1]) + (rv[q][j][2] * rv[q][j][2] + rv[q][j][3] * rv[q][j][3]); \
        ss = wave_sum(ss); if (lane == 0) RX[rrow[q]] = rsqrtf(ss * (1.0f / 1024.0f) + EPS); \
        _Pragma("unroll") for (int j = 0; j < 4; ++j) { u32x2 w; w.x = cvtpk(rv[q][j][0], rv[q][j][1]); w.y = cvtpk(rv[q][j][2], rv[q][j][3]); *(u32x2*)(XB + (size_t)rrow[q] * DM + j * 256 + lane * 4) = w; } } rowA += 2 * G * 8; } while (0)
    for (int t = b; t < J9; t += G) {
        const bool hasrow = rowA < MT; if (hasrow) ROWS_LOAD();
        if (t < J0) { const int j = t, k0 = (j & 15) * 64, n0 = (j >> 4) * 64; tile_mm<16>(MmVA{w_in, x_in, k0, n0 >> 8}, MmVB{cs, n0}, BT1 + (size_t)512 * 1024, 1024, k0, n0, tile, As, Bs, tid); }
        else if (t < J2) { const int j = t - J1; ttile128(w_in, NIN, x_in, BT1, 1024, (j & 7) * 128, (j >> 3) * 128, (j >> 3) * 128, tile, tid); }
        else if (t < J3) { const int j = t - J2; ttile128(w_ukv, 1024, g_kv, BT2KV, 256, (j & 1) * 128, (j >> 1) * 128, (j >> 1) * 128, tile, tid); }
        else if (t < J4) { const int j = t - J3; ttile128(w_out, 1024, nullptr, BTOUT, 1024, (j & 3) * 128, (j >> 2) * 128, (j >> 2) * 128, tile, tid); }
        else if (t < J5) { const int j = t - J4; ttile128(w_gate, DFF, g_pre_ffn, BTG, 1024, (j & 7) * 128, (j >> 3) * 128, (j >> 3) * 256, tile, tid); }
        else if (t < J6) { const int j = t - J5; ttile128(w_up, DFF, g_pre_ffn, BTG, 1024, (j & 7) * 128, (j >> 3) * 128, (j >> 3) * 256 + 128, tile, tid); }
        else if (t < J7) { const int j = t - J6; ttile128(w_down, 1024, nullptr, BTD, DFF, (j % 22) * 128, (j / 22) * 128, (j / 22) * 128, tile, tid); }
        else if (t < J8) { const int j = t - J7; ttile(SrcQ{w_uq, g_q}, BT2Q, 256, (j & 3) * 64, (j >> 2) * 64, tile); }
        else { const int j = t - J8; ttile(SrcKR{w_in, x_in}, BT1 + (size_t)1536 * 1024, 1024, (j & 15) * 64, (j >> 4) * 64, tile); }
        if (hasrow) ROWS_FINISH();
    }
    { float* RCOS = (float*)(ws + W_RCOS); float* RSIN = (float*)(ws + W_RSIN); float* TW = (float*)(ws + W_TW);
      bf16_t* F1 = (bf16_t*)(ws + W_F1); bf16_t* F2A = (bf16_t*)(ws + W_F2A); bf16_t* F2B = (bf16_t*)(ws + W_F2B);
      constexpr int E0 = 8192 * 16, E1 = E0 + 8192, E2 = E1 + 128 * 128, E3 = E2 + 128 * 256, E4 = E3 + 64 * 128;
      for (int e = b * 512 + tid; e < E4; e += G * 512) {
          if (e < E0) { const int pos = e >> 4, j = e & 15; const float inv = powf(10000.0f, -(float)j * (1.0f / 16.0f)); const float ang = (float)pos * inv; float s, c; sincosf(ang, &s, &c); RCOS[e] = c; RSIN[e] = s; }
          else if (e < E1) { const int m = e - E0; float s, c; sincospif((float)m * (1.0f / 4096.0f), &s, &c); TW[2 * m] = c; TW[2 * m + 1] = s; }
          else if (e < E2) { const int i = e - E1, mm = i >> 7, kx = i & 127, k1 = mm >> 1, ro = mm & 1, n1 = kx >> 1, ri = kx & 1; float s, c; sincospif((float)((n1 * k1) & 63) * (1.0f / 32.0f), &s, &c);
              const float v = (ro == ri) ? c : (ro == 0 ? s : -s); F1[i] = f2bf(v * 0.125f); }
          else if (e < E3) { const int i = e - E2, k2 = i >> 8, kx = i & 255, n2 = kx >> 1, ri = kx & 1; float s, c; sincospif((float)((n2 * k2) & 127) * (1.0f / 64.0f), &s, &c); F2A[i] = f2bf((ri ? s : c) * 0.08838834764831845f); }
          else { const int i = e - E3, k2 = i >> 7, kx = i & 127, n2 = kx >> 1, ri = kx & 1; float s, c; sincospif((float)((n2 * k2) & 63) * (1.0f / 32.0f), &s, &c); F2B[i] = f2bf((ri ? s : c) * 0.125f); }
      } }
    for (; rowA < MT;) { ROWS_LOAD(); ROWS_FINISH(); }
#undef ROWS_LOAD
#undef ROWS_FINISH
}

__device__ __forceinline__ void fold_fnet_tiles(KP p, unsigned char* shm) {
    KP_OPAQUE(p); int tid_ = threadIdx.x; asm volatile("" : "+v"(tid_));
    const int tid = tid_, G = gridDim.x, b = blockIdx.x, half = G / 2 > 0 ? G / 2 : 1; unsigned char* ws = p->ws;
    float* tile = (float*)shm; float* As = (float*)(shm + 32768); float* Bs = (float*)(shm + 32768 + 64 * 132 * 4);
    const float *w_fnet = p->in[8], *w_out = p->in[9]; bf16_t* BTOUT = (bf16_t*)(ws + W_BTOUT);
    __syncthreads();
    for (int j = b - half; j >= 0 && j < 128; j += half) { const int kb = (j & 7) * 64, n0 = (j >> 3) * 64; tile_mm<2>(MmFA{w_fnet, kb}, MmFB{w_out, kb >> 7, n0}, BTOUT, 1024, 512 + kb, n0, tile, As, Bs, tid); }
}

__device__ __forceinline__ void load_x1(KP p, const unsigned char* ws, int row, int lane, const f32x4 (&gpm)[4], f32x4 (&x1)[4]) {
    const float* xr = row < NPR ? p->in[0] + (size_t)row * DM : p->in[1] + (size_t)(row - NPR) * DM;
    const bf16_t* mr = (const bf16_t*)(ws + W_MIX) + (size_t)row * DM; const float* ssp = (const float*)(ws + W_SS2) + (size_t)row * 16;
    const f32x4 s0 = *(const f32x4*)ssp, s1 = *(const f32x4*)(ssp + 4), s2 = *(const f32x4*)(ssp + 8), s3 = *(const f32x4*)(ssp + 12); const f32x4 st = (s0 + s1) + (s2 + s3);
    const float rm = rsqrtf(((st[0] + st[1]) + (st[2] + st[3])) * (1.0f / 1024.0f) + EPS);
#pragma unroll
    for (int j = 0; j < 4; ++j) { const f32x4 xv = __builtin_nontemporal_load((const f32x4*)(xr + j * 256 + lane * 4)); const u32x2 mw = __builtin_nontemporal_load((const u32x2*)(mr + j * 256 + lane * 4));
        const f32x4 mv = {bflo(mw.x), bfhi(mw.x), bflo(mw.y), bfhi(mw.y)}; x1[j] = xv + mv * rm * gpm[j]; }
}
__device__ __forceinline__ void phase5(KP p, int row_lo, int row_hi, int blk_lo, int nblk) {
    int tid_ = threadIdx.x; asm volatile("" : "+v"(tid_));
    const int tid = tid_, lane = tid & 63, wid = tid >> 6, b = (int)blockIdx.x - blk_lo, G = nblk; unsigned char* ws = p->ws;
    if (b < 0 || b >= nblk) return;
    f32x4 gpm[4];
#pragma unroll
    for (int j = 0; j < 4; ++j) gpm[j] = *(const f32x4*)(p->in[10] + j * 256 + lane * 4);
    bf16_t* XB1 = (bf16_t*)(ws + W_XB); float* R2 = (float*)(ws + W_R2);
    for (int row0 = row_lo + b * 8 + wid; row0 < row_hi; row0 += 2 * G * 8) {
        const int row1 = row0 + G * 8 < row_hi ? row0 + G * 8 : row0;
        f32x4 xa[4], xb[4]; load_x1(p, ws, row0, lane, gpm, xa); load_x1(p, ws, row1, lane, gpm, xb); float sa = 0.f, sb = 0.f;
#pragma unroll
        for (int j = 0; j < 4; ++j) { sa += (xa[j][0] * xa[j][0] + xa[j][1] * xa[j][1]) + (xa[j][2] * xa[j][2] + xa[j][3] * xa[j][3]); sb += (xb[j][0] * xb[j][0] + xb[j][1] * xb[j][1]) + (xb[j][2] * xb[j][2] + xb[j][3] * xb[j][3]); }
        sa = wave_sum(sa); sb = wave_sum(sb);
        if (lane == 0) { R2[row0] = rsqrtf(sa * (1.0f / 1024.0f) + EPS); R2[row1] = rsqrtf(sb * (1.0f / 1024.0f) + EPS); }
#pragma unroll
        for (int j = 0; j < 4; ++j) { u32x2 w; w.x = cvtpk(xa[j][0], xa[j][1]); w.y = cvtpk(xa[j][2], xa[j][3]); *(u32x2*)(XB1 + (size_t)row0 * DM + j * 256 + lane * 4) = w;
            u32x2 v; v.x = cvtpk(xb[j][0], xb[j][1]); v.y = cvtpk(xb[j][2], xb[j][3]); *(u32x2*)(XB1 + (size_t)row1 * DM + j * 256 + lane * 4) = v; }
    }
}
__device__ __forceinline__ void phase9(KP p) {
    int tid_ = threadIdx.x; asm volatile("" : "+v"(tid_));
    const int tid = tid_, lane = tid & 63, wid = tid >> 6, G = gridDim.x, b = blockIdx.x; unsigned char* ws = p->ws;
    f32x4 gpf[4];
#pragma unroll
    for (int j = 0; j < 4; ++j) gpf[j] = *(const f32x4*)(p->in[17] + j * 256 + lane * 4);
    const bf16_t* XB1 = (const bf16_t*)(ws + W_XB); const bf16_t* FFN = (const bf16_t*)(ws + W_MIX); const float* SS3 = (const float*)(ws + W_SS3);
    for (int row0 = b * 8 + wid; row0 < MT; row0 += 2 * G * 8) {
        const int rows[2] = {row0, row0 + G * 8 < MT ? row0 + G * 8 : row0};
        u32x2 xw[2][4], fw[2][4]; f32x4 st[2];
#pragma unroll
        for (int q = 0; q < 2; ++q) { const float* ssp = SS3 + (size_t)rows[q] * 16; const f32x4 s0 = *(const f32x4*)ssp, s1 = *(const f32x4*)(ssp + 4), s2 = *(const f32x4*)(ssp + 8), s3 = *(const f32x4*)(ssp + 12); st[q] = (s0 + s1) + (s2 + s3);
#pragma unroll
            for (int j = 0; j < 4; ++j) { xw[q][j] = __builtin_nontemporal_load((const u32x2*)(XB1 + (size_t)rows[q] * DM + j * 256 + lane * 4)); fw[q][j] = __builtin_nontemporal_load((const u32x2*)(FFN + (size_t)rows[q] * DM + j * 256 + lane * 4)); } }
#pragma unroll
        for (int q = 0; q < 2; ++q) { const float rf = rsqrtf(((st[q][0] + st[q][1]) + (st[q][2] + st[q][3])) * (1.0f / 1024.0f) + EPS);
#pragma unroll
            for (int j = 0; j < 4; ++j) { const f32x4 xv = {bflo(xw[q][j].x), bfhi(xw[q][j].x), bflo(xw[q][j].y), bfhi(xw[q][j].y)}, fv = {bflo(fw[q][j].x), bfhi(fw[q][j].x), bflo(fw[q][j].y), bfhi(fw[q][j].y)};
                __builtin_nontemporal_store(xv + fv * rf * gpf[j], (f32x4*)(p->out + (size_t)rows[q] * DM + j * 256 + lane * 4)); } }
    }
}

__device__ __forceinline__ int crow(int r, int hi) { return (r & 3) + 8 * (r >> 2) + 4 * hi; }
__device__ __forceinline__ bf16x8 ldsB(const unsigned* T, int r0, int n) { u32x4 w = {T[(r0 + 0) * 128 + n], T[(r0 + 1) * 128 + n], T[(r0 + 2) * 128 + n], T[(r0 + 3) * 128 + n]}; return *reinterpret_cast<bf16x8*>(&w); }
__device__ __forceinline__ void fft1_decode(int it, int& chb, int& seqbase, int& N2, int& n2, int& tws) {
    chb = it & 3; const int sn = it >> 2;
    if (sn < 256) { seqbase = (sn >> 7) * 8192; N2 = 128; n2 = sn & 127; tws = 1; } else { const int s2 = sn - 256; seqbase = NPR + (s2 >> 6) * 4096; N2 = 64; n2 = s2 & 63; tws = 2; }
}
__device__ __forceinline__ void fft_stage1(KP p, unsigned char* shm) {
    int tid_ = threadIdx.x; asm volatile("" : "+v"(tid_));
    const int tid = tid_, lane = tid & 63, wid = __builtin_amdgcn_readfirstlane(tid >> 6), l32 = lane & 31, hi = lane >> 5, G = gridDim.x; unsigned char* ws = p->ws;
    const unsigned* VC = (const unsigned*)(ws + W_VC); unsigned* T1 = (unsigned*)(ws + W_XB); const bf16_t* F1 = (const bf16_t*)(ws + W_F1); const float* TW = (const float*)(ws + W_TW);
    unsigned* T = (unsigned*)shm;
    const int mb = wid & 3, cb0 = (wid >> 2) * 2;
    bf16x8 a[8];
#pragma unroll
    for (int ks = 0; ks < 8; ++ks) a[ks] = *(const bf16x8*)(F1 + (32 * mb + l32) * 128 + 16 * ks + 8 * hi);
    u32x4 pre[4];
#define F1_LOAD(it_) do { int chb_, sb_, N2_, n2_, tw_; fft1_decode(it_, chb_, sb_, N2_, n2_, tw_); _Pragma("unroll") for (int i = 0; i < 4; ++i) { const int idx = tid + 512 * i, r = idx >> 5, c4 = idx & 31; \
        pre[i] = *(const u32x4*)(VC + (size_t)(sb_ + N2_ * r + n2_) * 512 + chb_ * 128 + c4 * 4); } } while (0)
    if ((int)blockIdx.x < 2048) F1_LOAD((int)blockIdx.x);
    for (int it = blockIdx.x; it < 2048; it += G) {
        int chb, seqbase, N2, n2, tws; fft1_decode(it, chb, seqbase, N2, n2, tws);
        __syncthreads();
#pragma unroll
        for (int i = 0; i < 4; ++i) { const int idx = tid + 512 * i, r = idx >> 5, c4 = idx & 31; *(u32x4*)(T + r * 128 + c4 * 4) = pre[i]; }
        __syncthreads();
        if (it + G < 2048) F1_LOAD(it + G);
#pragma unroll
        for (int c = 0; c < 2; ++c) { const int n = 32 * (cb0 + c) + l32; f32x16 acc = {};
#pragma unroll
            for (int ks = 0; ks < 8; ++ks) acc = __builtin_amdgcn_mfma_f32_32x32x16_bf16(a[ks], ldsB(T, 8 * ks + 4 * hi, n), acc, 0, 0, 0);
#pragma unroll
            for (int q = 0; q < 4; ++q)
#pragma unroll
                for (int e = 0; e < 2; ++e) { const int k1 = 16 * mb + 4 * q + 2 * hi + e; const float re = acc[4 * q + 2 * e], im = acc[4 * q + 2 * e + 1];
                    const int ti = (n2 * k1 * tws) & 8191; const float cc = TW[2 * ti], sn_ = TW[2 * ti + 1];
                    T1[(size_t)(seqbase + k1 * N2 + n2) * 512 + chb * 128 + n] = cvtpk(re * cc + im * sn_, im * cc - re * sn_); } }
    }
#undef F1_LOAD
    __syncthreads();
}
template <int N2> __device__ __forceinline__ void fft_stage2_loop(KP p, unsigned* T, int it0, int it_end, int tid, int wid, int l32, int hi) {
    unsigned char* ws = p->ws; const unsigned* T1 = (const unsigned*)(ws + W_XB); bf16_t* AF = (bf16_t*)(ws + W_AF);
    const bf16_t* F2 = (const bf16_t*)(ws + (N2 == 128 ? W_F2A : W_F2B)); const int G = gridDim.x;
    constexpr int NL = N2 / 16, NMB = N2 / 32, NCB = (N2 == 128) ? 2 : 1, KS = N2 / 8;
    const int mb = wid & (NMB - 1), cbase = (N2 == 128) ? (wid >> 2) * 2 : (wid >> 1);
    u32x4 pre[NL];
#define F2_LOAD(it_) do { const int chb_ = (it_) & 3, k1_ = ((it_) >> 2) & 63, sq_ = (it_) >> 8, sb_ = (N2 == 128) ? sq_ * 8192 : NPR + (sq_ - 2) * 4096; _Pragma("unroll") for (int i = 0; i < NL; ++i) { const int idx = tid + 512 * i, r = idx >> 5, c4 = idx & 31; \
        pre[i] = *(const u32x4*)(T1 + (size_t)(sb_ + k1_ * N2 + r) * 512 + chb_ * 128 + c4 * 4); } } while (0)
    if (it0 < it_end) F2_LOAD(it0);
    for (int it = it0; it < it_end; it += G) { const int chb = it & 3, k1 = (it >> 2) & 63, sq = it >> 8, seqbase = (N2 == 128) ? sq * 8192 : NPR + (sq - 2) * 4096;
        __syncthreads();
#pragma unroll
        for (int i = 0; i < NL; ++i) { const int idx = tid + 512 * i, r = idx >> 5, c4 = idx & 31; *(u32x4*)(T + r * 128 + c4 * 4) = pre[i]; }
        __syncthreads();
        if (it + G < it_end) F2_LOAD(it + G);
#pragma unroll
        for (int c = 0; c < NCB; ++c) { const int n = 32 * (cbase + c) + l32; f32x16 acc = {};
#pragma unroll
            for (int ks = 0; ks < KS; ++ks) { const bf16x8 a = *(const bf16x8*)(F2 + (32 * mb + l32) * (2 * N2) + 16 * ks + 8 * hi);
                acc = __builtin_amdgcn_mfma_f32_32x32x16_bf16(a, ldsB(T, 8 * ks + 4 * hi, n), acc, 0, 0, 0); }
#pragma unroll
            for (int r = 0; r < 16; ++r) { const int k2 = 32 * mb + crow(r, hi); AF[(size_t)(seqbase + k1 + 64 * k2) * 1024 + 512 + chb * 128 + n] = f2bf(acc[r]); } }
    }
#undef F2_LOAD
    __syncthreads();
}
__device__ __forceinline__ void fft_stage2(KP p, unsigned char* shm) {
    int tid_ = threadIdx.x; asm volatile("" : "+v"(tid_));
    const int tid = tid_, lane = tid & 63, wid = __builtin_amdgcn_readfirstlane(tid >> 6), l32 = lane & 31, hi = lane >> 5, G = gridDim.x;
    unsigned* T = (unsigned*)shm;
    __syncthreads();
    fft_stage2_loop<128>(p, T, (int)blockIdx.x, 512, tid, wid, l32, hi);
    { int it0 = blockIdx.x; while (it0 < 512) it0 += G; fft_stage2_loop<64>(p, T, it0, 1536, tid, wid, l32, hi); }
}

namespace att {
constexpr int KVBLK = 64, SHM_V = 8192, SHM_K = 16384;
constexpr float THRL = 11.5f;
#define KSWZ(row, colB) ((row) * 256 + ((colB) ^ (((row) & 15) << 4)))
#define SBAR() __builtin_amdgcn_sched_barrier(0)
template <bool FIRST> __device__ __forceinline__ void partialSM(f32x16& p0, f32x16& p1, float& m_reg, float& alpha) {
    float pmax = p0[0];
#pragma unroll
    for (int r = 1; r < 16; ++r) pmax = fmaxf(pmax, p0[r]);
#pragma unroll
    for (int r = 0; r < 16; ++r) pmax = fmaxf(pmax, p1[r]);
    { auto rr = __builtin_amdgcn_permlane32_swap(__float_as_uint(pmax), __float_as_uint(pmax), false, false); pmax = fmaxf(__uint_as_float(rr[0]), __uint_as_float(rr[1])); }
    if (!FIRST && __builtin_expect(__all(pmax <= THRL), 1)) { alpha = 1.f; }
    else { const float d = FIRST ? pmax : fmaxf(pmax, 0.f); alpha = FIRST ? 1.f : __builtin_amdgcn_exp2f(-d); m_reg += d;
#pragma unroll
        for (int r = 0; r < 16; ++r) p0[r] = p0[r] - d;
#pragma unroll
        for (int r = 0; r < 16; ++r) p1[r] = p1[r] - d; }
#pragma unroll
    for (int r = 0; r < 16; ++r) p0[r] = __builtin_amdgcn_exp2f(p0[r]);
}
__device__ __forceinline__ void finishSM(f32x16& p0, f32x16& p1, float alpha, float& l_reg, bf16x8& pa0, bf16x8& pa1, bf16x8& pa2, bf16x8& pa3) {
#pragma unroll
    for (int r = 0; r < 16; ++r) p1[r] = __builtin_amdgcn_exp2f(p1[r]);
    float ps = 0;
#pragma unroll
    for (int r = 0; r < 16; ++r) ps += p0[r];
#pragma unroll
    for (int r = 0; r < 16; ++r) ps += p1[r];
    { auto rr = __builtin_amdgcn_permlane32_swap(__float_as_uint(ps), __float_as_uint(ps), false, false); ps = __uint_as_float(rr[0]) + __uint_as_float(rr[1]); }
    l_reg = l_reg * alpha + ps;
#define PK4(P, BASE, OUT) do { unsigned a0 = cvtpk(P[BASE + 0], P[BASE + 1]), a1 = cvtpk(P[BASE + 2], P[BASE + 3]);   \
    unsigned b0 = cvtpk(P[BASE + 4], P[BASE + 5]), b1 = cvtpk(P[BASE + 6], P[BASE + 7]);                              \
    auto r0 = __builtin_amdgcn_permlane32_swap(a0, b0, false, false); auto r1 = __builtin_amdgcn_permlane32_swap(a1, b1, false, false); \
    u32x4 w = {r0[0], r1[0], r0[1], r1[1]}; OUT = *reinterpret_cast<bf16x8*>(&w); } while (0)
    PK4(p0, 0, pa0); PK4(p0, 8, pa1); PK4(p1, 0, pa2); PK4(p1, 8, pa3);
#undef PK4
}
__device__ __forceinline__ void qkt(f32x16& p0, f32x16& p1, const char* Ks, const bf16x8* qr, int r32, int hi, float minit) {
#pragma unroll
    for (int r = 0; r < 16; ++r) { p0[r] = minit; p1[r] = minit; }
#pragma unroll
    for (int d0 = 0; d0 < 6; ++d0) { const int cb = (d0 * 16 + hi * 8) * 2;
        bf16x8 b0 = *reinterpret_cast<const bf16x8*>(Ks + KSWZ(r32, cb));
        bf16x8 b1 = *reinterpret_cast<const bf16x8*>(Ks + KSWZ(32 + r32, cb));
        p0 = __builtin_amdgcn_mfma_f32_32x32x16_bf16(b0, qr[d0], p0, 0, 0, 0);
        p1 = __builtin_amdgcn_mfma_f32_32x32x16_bf16(b1, qr[d0], p1, 0, 0, 0); }
}
__device__ __forceinline__ int v_st(int k, int c) { const int kk = (k & ~0xC) | ((k & 4) << 1) | ((k & 8) >> 1); return ((kk >> 3) * 2 + (c >> 5)) * 512 + ((kk & 7) * 32 + (c & 31)) * 2; }
__device__ __forceinline__ int v_rd_base(int lane) { return ((lane & 3) << 3) | (((lane >> 2) & 3) << 6) | (((lane >> 4) & 1) << 5) | (((lane >> 5) & 1) << 8); }
constexpr int v_rd_off(int d0, int ks, int half) { return d0 * 512 + ks * 2048 + half * 1024; }
template <int OFF> __device__ __forceinline__ s16x4 tr_read(int vb) { s16x4 r; asm volatile("ds_read_b64_tr_b16 %0, %1 offset:%2" : "=&v"(r) : "v"(vb), "i"(OFF) : "memory"); return r; }
template <int D0> __device__ __forceinline__ void pv_one(f32x16& od, int vb, bf16x8 pa0, bf16x8 pa1, bf16x8 pa2, bf16x8 pa3) {
    const s16x4 l0 = tr_read<v_rd_off(D0, 0, 0)>(vb), h0 = tr_read<v_rd_off(D0, 0, 1)>(vb), l1 = tr_read<v_rd_off(D0, 1, 0)>(vb), h1 = tr_read<v_rd_off(D0, 1, 1)>(vb);
    const s16x4 l2 = tr_read<v_rd_off(D0, 2, 0)>(vb), h2 = tr_read<v_rd_off(D0, 2, 1)>(vb), l3 = tr_read<v_rd_off(D0, 3, 0)>(vb), h3 = tr_read<v_rd_off(D0, 3, 1)>(vb);
    asm volatile("s_waitcnt lgkmcnt(0)" ::: "memory"); SBAR();
#define PK(L, H) (bf16x8){L[0], L[1], L[2], L[3], H[0], H[1], H[2], H[3]}
    od = __builtin_amdgcn_mfma_f32_32x32x16_bf16(pa0, PK(l0, h0), od, 0, 0, 0);
    od = __builtin_amdgcn_mfma_f32_32x32x16_bf16(pa1, PK(l1, h1), od, 0, 0, 0);
    od = __builtin_amdgcn_mfma_f32_32x32x16_bf16(pa2, PK(l2, h2), od, 0, 0, 0);
    od = __builtin_amdgcn_mfma_f32_32x32x16_bf16(pa3, PK(l3, h3), od, 0, 0, 0);
#undef PK
}
__device__ __forceinline__ void pv_d0(f32x16* o, int vb, bf16x8 pa0, bf16x8 pa1, bf16x8 pa2, bf16x8 pa3) { pv_one<0>(o[0], vb, pa0, pa1, pa2, pa3); pv_one<1>(o[1], vb, pa0, pa1, pa2, pa3); }

__device__ __forceinline__ void body(const bf16_t* __restrict__ Qb, const bf16_t* __restrict__ KNh, const bf16_t* __restrict__ KRs, const bf16_t* __restrict__ Vh, bf16_t* __restrict__ Ob, int seq, char* lds, int qpos0, const float* RCOS, const float* RSIN) {
    int tid_ = threadIdx.x; asm volatile("" : "+v"(tid_));
    const int tid = tid_, wid = __builtin_amdgcn_readfirstlane(tid >> 6), lane = tid & 63, r32 = lane & 31, hi = lane >> 5;
    char* V_lds = lds; char* K_lds = lds + 3 * SHM_V;
    float* wsf = (float*)(lds + 3 * SHM_V + 3 * SHM_K) + wid * 64; float* li_l = wsf; float* al_l = wsf + 32;
    float m_reg = 0.f, l_reg = 0; f32x16 o[2] = {}; bf16x8 qr[6];
    const bf16_t* Qw = Qb + (size_t)(wid * 32 + r32) * 96 + hi * 8;
#pragma unroll
    for (int d0 = 0; d0 < 6; ++d0) qr[d0] = *(const bf16x8*)(Qw + d0 * 16);
#pragma unroll
    for (int d0 = 4; d0 < 6; ++d0) { const int i4 = (2 * (d0 - 4) + hi) * 4, pos = qpos0 + wid * 32 + r32; const f32x4 c4 = *(const f32x4*)(RCOS + pos * 16 + i4), s4 = *(const f32x4*)(RSIN + pos * 16 + i4);
        const u32x4 w = *reinterpret_cast<const u32x4*>(&qr[d0]); const f32x4 x1 = {bflo(w.x), bfhi(w.x), bflo(w.y), bfhi(w.y)}, x2 = {bflo(w.z), bfhi(w.z), bflo(w.w), bfhi(w.w)};
        const u32x4 o = pack8(x1 * c4 - x2 * s4, x2 * c4 + x1 * s4); qr[d0] = *reinterpret_cast<const bf16x8*>(&o); }
    const int vr = tid >> 3, vc = (tid & 7) * 8, vst = v_st(vr, vc);
    const char* vp = (const char*)(Vh + (size_t)vr * 64 + vc);
    const int cA = tid, rA = cA / 12, pA = cA - rA * 12; const int cB = 512 + (tid & 255), rB = cB / 12, pB = cB - rB * 12;
    const char* kpA = pA < 8 ? (const char*)(KNh + (size_t)rA * 64 + pA * 8) : (const char*)(KRs + (size_t)rA * 32 + (pA - 8) * 8); const size_t ksA = pA < 8 ? 8192 : 4096; const int kdA = KSWZ(rA, pA * 16);
    const bool hasB = wid < 4;
    const char* kpB = !hasB ? kpA : (pB < 8 ? (const char*)(KNh + (size_t)rB * 64 + pB * 8) : (const char*)(KRs + (size_t)rB * 32 + (pB - 8) * 8)); const size_t ksB = !hasB ? ksA : (pB < 8 ? 8192 : 4096); const int kdB = !hasB ? kdA : KSWZ(rB, pB * 16);
    const int vb0 = (int)(uintptr_t)V_lds + v_rd_base(lane);
    struct { bf16x8 vs, ka, kb; } sr_[2];
#define SLOAD(i, j) do { sr_[i].vs = *(const bf16x8*)(vp + (size_t)(j) * 8192); sr_[i].ka = *(const bf16x8*)(kpA + (size_t)(j) * ksA); sr_[i].kb = *(const bf16x8*)(kpB + (size_t)(j) * ksB); } while (0)
#define SWRITE(b, i) do { *(bf16x8*)(V_lds + (b) * SHM_V + vst) = sr_[i].vs; *(bf16x8*)(K_lds + (b) * SHM_K + kdA) = sr_[i].ka; *(bf16x8*)(K_lds + (b) * SHM_K + kdB) = sr_[i].kb; } while (0)
#define RESC(a) do { if (__any((a) < 1.f)) { if (hi == 0) al_l[r32] = (a); asm volatile("s_waitcnt lgkmcnt(0)" ::: "memory"); \
    _Pragma("unroll") for (int d = 0; d < 2; ++d) _Pragma("unroll") for (int r = 0; r < 16; ++r) o[d][r] *= al_l[crow(r, hi)]; } } while (0)
#define NEXT3(x) ((x) == 2 ? 0 : (x) + 1)
    f32x16 pA0, pA1, pB0, pB1; float alA, alB; bf16x8 pa0, pa1, pa2, pa3; const int NT = seq / KVBLK;
    __syncthreads();
    SLOAD(0, 0); SLOAD(1, 1); asm volatile("s_waitcnt vmcnt(3)" ::: "memory"); SWRITE(0, 0); SLOAD(0, 2);
    __syncthreads();
    qkt(pA0, pA1, K_lds, qr, r32, hi, 0.f); partialSM<true>(pA0, pA1, m_reg, alA);
    SWRITE(1, 1); SLOAD(1, 3);
    int bc = 1;
    for (int j = 1; j + 1 < NT; j += 2) {
        { const int bn = NEXT3(bc), bp = (bc == 0 ? 2 : bc - 1);
          __syncthreads();
          SBAR(); qkt(pB0, pB1, K_lds + bc * SHM_K, qr, r32, hi, -m_reg);
          finishSM(pA0, pA1, alA, l_reg, pa0, pa1, pa2, pa3); SBAR();
          pv_d0(o, vb0 + bp * SHM_V, pa0, pa1, pa2, pa3); partialSM<false>(pB0, pB1, m_reg, alB);
          SBAR(); SWRITE(bn, 0); SLOAD(0, (j + 3 < NT ? j + 3 : NT - 1));
          RESC(alB); bc = bn; }
        { const int bn = NEXT3(bc), bp = (bc == 0 ? 2 : bc - 1);
          __syncthreads();
          SBAR(); qkt(pA0, pA1, K_lds + bc * SHM_K, qr, r32, hi, -m_reg);
          finishSM(pB0, pB1, alB, l_reg, pa0, pa1, pa2, pa3); SBAR();
          pv_d0(o, vb0 + bp * SHM_V, pa0, pa1, pa2, pa3); partialSM<false>(pA0, pA1, m_reg, alA);
          SBAR(); SWRITE(bn, 1); SLOAD(1, (j + 4 < NT ? j + 4 : NT - 1));
          RESC(alA); bc = bn; }
    }
    { const int bp = (bc == 0 ? 2 : bc - 1);
      __syncthreads();
      SBAR(); qkt(pB0, pB1, K_lds + bc * SHM_K, qr, r32, hi, -m_reg);
      finishSM(pA0, pA1, alA, l_reg, pa0, pa1, pa2, pa3); SBAR();
      pv_d0(o, vb0 + bp * SHM_V, pa0, pa1, pa2, pa3); partialSM<false>(pB0, pB1, m_reg, alB);
      RESC(alB);
      finishSM(pB0, pB1, alB, l_reg, pa0, pa1, pa2, pa3); SBAR();
      pv_d0(o, vb0 + bc * SHM_V, pa0, pa1, pa2, pa3); }
    asm volatile("s_waitcnt vmcnt(0)" ::: "memory");
    if (hi == 0) li_l[r32] = l_reg; asm volatile("s_waitcnt lgkmcnt(0)" ::: "memory");
    float rli[16];
#pragma unroll
    for (int r = 0; r < 16; ++r) rli[r] = __builtin_amdgcn_rcpf(li_l[crow(r, hi)]);
    bf16_t* Ow = Ob + (size_t)(wid * 32) * 1024;
#pragma unroll
    for (int r = 0; r < 16; ++r) { const int orow = crow(r, hi);
#pragma unroll
        for (int d0 = 0; d0 < 2; ++d0) Ow[(size_t)orow * 1024 + d0 * 32 + r32] = f2bf(o[d0][r] * rli[r]); }
#undef SLOAD
#undef SWRITE
#undef RESC
#undef NEXT3
}
}

__device__ __forceinline__ void attn_phase(KP p, unsigned char* shm) {
    const int G = gridDim.x, b = blockIdx.x; unsigned char* ws = p->ws; unsigned char* od = (unsigned char*)p->out;
    const bf16_t* Q = (const bf16_t*)(od + O_Q); const bf16_t* KN = (const bf16_t*)(od + O_KN); const bf16_t* VV = (const bf16_t*)(od + O_VV); const bf16_t* KRP = (const bf16_t*)(ws + W_KRP); bf16_t* AF = (bf16_t*)(ws + W_AF);
    for (int it = b; it < 1024; it += G) {
        int pair, qb, seqbase, len, head;
        if (G == 256) { const int j = it >> 8, xcd = b & 7, slot = b >> 3;
            if (j < 2) { pair = j * 8 + xcd; qb = slot; seqbase = (pair >> 3) * 8192; len = 8192; }
            else { pair = (j - 2) * 16 + 2 * xcd + (slot >> 4); qb = slot & 15; seqbase = NPR + (pair >> 3) * 4096; len = 4096; }
        } else if (it < 512) { pair = it >> 5; qb = it & 31; seqbase = (pair >> 3) * 8192; len = 8192; }
        else { const int i2 = it - 512; pair = i2 >> 4; qb = i2 & 15; seqbase = NPR + (pair >> 3) * 4096; len = 4096; }
        head = pair & 7;
        att::body(Q + ((size_t)head * MT + seqbase + qb * 256) * 96, KN + ((size_t)head * MT + seqbase) * 64, KRP + (size_t)seqbase * 32, VV + ((size_t)head * MT + seqbase) * 64,
                  AF + (size_t)(seqbase + qb * 256) * 1024 + head * 64, len, (char*)shm, qb * 256, (const float*)(ws + W_RCOS), (const float*)(ws + W_RSIN));
    }
}


#ifndef DBG_STOP
#define DBG_STOP 0
#endif
__device__ __forceinline__ float bfv(const bf16_t* p, size_t i) { return __uint_as_float(((unsigned)p[i]) << 16); }
__device__ __forceinline__ void dbg_probe(KP p, int k) {
    unsigned char* ws = p->ws; float* out = p->out; const size_t n = (size_t)MT * DM;
    for (size_t i = (size_t)blockIdx.x * 512 + threadIdx.x; i < n; i += (size_t)gridDim.x * 512) { const size_t row = i >> 10; const int c = (int)(i & 1023); float v = 0.f;
        if (k == 1) v = bfv((const bf16_t*)(ws + W_VC), i) + bfv((const bf16_t*)(ws + W_CQ), row * 256 + (c & 255)) + bfv((const bf16_t*)(ws + W_CKV), row * 256 + (c & 255)) + bfv((const bf16_t*)(ws + W_KRP), row * 32 + (c & 31)) + ((const float*)(ws + W_SSP))[row * 8 + (c & 7)];
        if (k == 10) v = bfv((const bf16_t*)(ws + W_XB), i) + ((const float*)(ws + W_RX))[row];
        if (k == 11) v = bfv((const bf16_t*)(ws + W_BT1), i) + bfv((const bf16_t*)(ws + W_BTOUT), i) + bfv((const bf16_t*)(ws + W_BTG), i % ((size_t)DFF * 1024)) + bfv((const bf16_t*)(ws + W_BTD), i % ((size_t)DFF * 1024)) + bfv((const bf16_t*)(ws + W_BT2Q), i % (768 * 256)) + ((const float*)(ws + W_RCOS))[i % (8192 * 16)] + ((const float*)(ws + W_TW))[i % 16384] + bfv((const bf16_t*)(ws + W_F2A), i % 32768);
        if (k == 2) v = bfv((const bf16_t*)(ws + W_XB), i);
        if (k == 3) v = bfv((const bf16_t*)(ws + W_AF), i);
        if (k == 4) v = bfv((const bf16_t*)(ws + W_MIX), i) + ((const float*)(ws + W_SS2))[row * 16 + (c & 15)];
        if (k == 5) v = bfv((const bf16_t*)(ws + W_XB), i) + ((const float*)(ws + W_R2))[row];
        if (k == 8) v = bfv((const bf16_t*)(ws + W_XB), i) + ((const float*)(ws + W_SS3))[row * 16 + (c & 15)];
        out[i] = v; }
}
__device__ __forceinline__ void dbg_probe_qkv(KP p, int step) {
    unsigned char* ws = p->ws; float* out = p->out; const size_t n = (size_t)MT * DM; float* tmp = (float*)(ws + 96 * MiB); const unsigned char* od = (const unsigned char*)p->out;
    for (size_t i = (size_t)blockIdx.x * 512 + threadIdx.x; i < n; i += (size_t)gridDim.x * 512) {
        if (step == 0) { float v = bfv((const bf16_t*)od, i); if (i < (size_t)24 * 1048576) v += bfv((const bf16_t*)(od + 64 * MiB), i); tmp[i] = v; }
        else out[i] = tmp[i]; }
}
#define XB_TMO      128
#define XB_XCNT(j)  (256  + 64 * (j))
#define XB_XSUB(j)  (1280 + 64 * (j))
#define XB_XGEN(j)  (2304 + 64 * (j))
#define XB_TOP      3328
#define XB_TOPGEN   3392
#define XCD_BAR_WORDS 3456
#define XB_SPIN_CAP (1u << 18)
#define XLAS __attribute__((address_space(3)))

__device__ __forceinline__ unsigned xb_ld(unsigned* p)              { return __hip_atomic_load(p, __ATOMIC_RELAXED, __HIP_MEMORY_SCOPE_AGENT); }
__device__ __forceinline__ unsigned xb_add(unsigned* p, unsigned v) { return __hip_atomic_fetch_add(p, v, __ATOMIC_RELAXED, __HIP_MEMORY_SCOPE_AGENT); }
__device__ __forceinline__ unsigned xb_xcc_id() { return (unsigned)__builtin_amdgcn_s_getreg((3 << 11) | 20) & 0xFu; }
#define XB_SPIN(cond, bar) do { unsigned _sp = 0; while (cond) { __builtin_amdgcn_s_sleep(1); \
    if ((++_sp & 255u) == 0u) { if (xb_ld(&(bar)[XB_TMO])) break; if (_sp > XB_SPIN_CAP) { atomicAdd(&(bar)[XB_TMO], 1u); break; } } } } while (0)

struct XcdBarrier {
    unsigned* bar; unsigned x;
    volatile XLAS unsigned* st;
};

__device__ __forceinline__ XcdBarrier xcd_barrier_post(unsigned* bar, volatile XLAS unsigned* st) {
    XcdBarrier b; b.bar = bar; b.x = xb_xcc_id(); b.st = st;
    if (threadIdx.x == 0) (void)xb_add(&bar[XB_XCNT(b.x)], 1u);
    return b;
}
__device__ __forceinline__ void xcd_barrier_complete(unsigned* bar, unsigned x, unsigned& nloc, unsigned& nx) {
    const unsigned G = gridDim.x * gridDim.y * gridDim.z;
    unsigned sum, cnt, mine, sp = 0u;
    for (;;) {
        sum = 0u; cnt = 0u; mine = 0u;
#pragma unroll
        for (unsigned j = 0; j < 16; ++j) { const unsigned c = xb_ld(&bar[XB_XCNT(j)]); sum += c; cnt += (c > 0u) ? 1u : 0u; mine = (j == x) ? c : mine; }
        if (sum == G) break;
        __builtin_amdgcn_s_sleep(1);
        if ((++sp & 255u) == 0u) { if (xb_ld(&bar[XB_TMO])) break; if (sp > XB_SPIN_CAP) { atomicAdd(&bar[XB_TMO], 1u); break; } }
    }
    nloc = mine > 0u ? mine : 1u; nx = cnt > 0u ? cnt : 1u;
}

__device__ __forceinline__ void xcd_barrier(const XcdBarrier& b) {
    asm volatile("s_waitcnt vmcnt(0)" ::: "memory");
    __syncthreads();
    if (threadIdx.x == 0) {
        unsigned* bar = b.bar;
        __builtin_amdgcn_s_waitcnt(0);
        unsigned nloc = b.st[0], nx = b.st[1];
        if (nloc == 0u) { xcd_barrier_complete(bar, b.x, nloc, nx); b.st[0] = nloc; b.st[1] = nx; }
        const unsigned old = xb_add(&bar[XB_XSUB(b.x)], 1u);
        const unsigned gen = old / nloc;
        if (old + 1u == (gen + 1u) * nloc) {
            __builtin_amdgcn_fence(__ATOMIC_RELEASE, "agent");
            asm volatile("s_waitcnt vmcnt(0)" ::: "memory");
            const unsigned og = xb_add(&bar[XB_TOP], 1u);
            const unsigned tg = og / nx;
            if (og + 1u == (tg + 1u) * nx) xb_add(&bar[XB_TOPGEN], 1u);
            else XB_SPIN(xb_ld(&bar[XB_TOPGEN]) == tg, bar);
            __builtin_amdgcn_fence(__ATOMIC_ACQUIRE, "agent");
            xb_add(&bar[XB_XGEN(b.x)], 1u);
            asm volatile("s_waitcnt vmcnt(0)" ::: "memory");
        } else {
            XB_SPIN(xb_ld(&bar[XB_XGEN(b.x)]) == gen, bar);
            __builtin_amdgcn_fence(__ATOMIC_ACQUIRE, "agent");
            asm volatile("s_waitcnt vmcnt(0)" ::: "memory");
        }
    }
    __syncthreads();
}

#ifndef OWN_BAR
#define OWN_BAR 1
#endif
#ifndef PHM
#define PHM 0xFFFF
#endif
#ifndef DUPM
#define DUPM 0
#endif
#define PH(n) for (int rep_ = 0; rep_ < 1 + ((DUPM >> (n)) & 1); ++rep_) if constexpr ((PHM >> (n)) & 1)
__global__ void __launch_bounds__(512) mega_fwd(Params p_unused) {
    extern __shared__ __attribute__((aligned(16))) unsigned char shm[];
#if !OWN_BAR
    cg::grid_group grid = cg::this_grid();
#endif
    PG8_LAS unsigned char* lds = (PG8_LAS unsigned char*)shm;
    const int G = gridDim.x, b = blockIdx.x;
    KP p = (KP)__builtin_amdgcn_kernarg_segment_ptr();

#define TSTAMP(k) do { if constexpr (DIAG_A >= 0) { if (blockIdx.x == 0 && threadIdx.x == 0) ((unsigned long long*)(p->ws + W_TS))[k] = wall_clock64(); } } while (0)
#if OWN_BAR
    if (threadIdx.x < 2) ((volatile XLAS unsigned*)(lds + 131072))[threadIdx.x] = 0u;
    __syncthreads();
    { KP_OPAQUE(p); (void)xcd_barrier_post((unsigned*)(p->ws + W_BAR), (volatile XLAS unsigned*)(lds + 131072)); }
#define GRID_SYNC(gen) do { XcdBarrier xb_; xb_.bar = (unsigned*)(p->ws + W_BAR); xb_.x = xb_xcc_id(); xb_.st = (volatile XLAS unsigned*)(lds + 131072); xcd_barrier(xb_); } while (0)
#else
#define GRID_SYNC(gen) do { asm volatile("s_waitcnt vmcnt(0) lgkmcnt(0)" ::: "memory"); grid.sync(); __builtin_amdgcn_fence(__ATOMIC_ACQUIRE, "agent"); asm volatile("s_waitcnt vmcnt(0)" ::: "memory"); } while (0)
#endif
    TSTAMP(0);
    PH(0) phase0(p, shm);
    GRID_SYNC(1); TSTAMP(1);
    if constexpr (DBG_STOP == 10 || DBG_STOP == 11) { dbg_probe(p, DBG_STOP); return; }
    PH(1) { fold_fnet_tiles(p, shm); }
    PH(1) {
        KP_OPAQUE(p); unsigned char* ws = p->ws;
        pg8::Gemm g{(const bf16_t*)(ws + W_XB), (const bf16_t*)(ws + W_BT1), MT, 1792, 1024}; pg8::StaticOrder S; S.init(MT, 1792, G, b);
        Epi1 E{(const float*)(ws + W_RX), (bf16_t*)(ws + W_CQ), (bf16_t*)(ws + W_CKV), (float*)(ws + W_SSP), (bf16_t*)(ws + W_VC), (bf16_t*)(ws + W_KRP), (const float*)(ws + W_RCOS), (const float*)(ws + W_RSIN)};
        pg8::gemm_phase<Epi1, pg8::StaticOrder, GEMM_ALIGN, GEMM_SP2>(lds, g, S, E);
    }
    GRID_SYNC(2); TSTAMP(2);
    if constexpr (DBG_STOP == 1) { dbg_probe(p, 1); return; }
    {
        PH(2) { KP_OPAQUE(p); unsigned char* ws = p->ws; unsigned char* od = (unsigned char*)p->out;
          pg8::Gemm g{(const bf16_t*)(ws + W_CQ), (const bf16_t*)(ws + W_BT2Q), MT, 768, 256}; pg8::StaticOrder S; S.init(MT, 768, G, b);
          Epi2Q E{(const float*)(ws + W_SSP), (bf16_t*)(od + O_Q)}; pg8::gemm_phase<Epi2Q, pg8::StaticOrder, GEMM_ALIGN, false>(lds, g, S, E); }
        PH(3) { KP_OPAQUE(p); unsigned char* ws = p->ws; unsigned char* od = (unsigned char*)p->out;
          pg8::Gemm g{(const bf16_t*)(ws + W_CKV), (const bf16_t*)(ws + W_BT2KV), MT, 1024, 256}; pg8::StaticOrder S; S.init(MT, 1024, G, b);
          Epi2KV E{(const float*)(ws + W_SSP), (bf16_t*)(od + O_KN), (bf16_t*)(od + O_VV)}; pg8::gemm_phase<Epi2KV, pg8::StaticOrder, GEMM_ALIGN, false>(lds, g, S, E); }
        PH(4) { KP_OPAQUE(p); fft_stage1(p, shm); }
    }
    GRID_SYNC(3); TSTAMP(3);
    if constexpr (DBG_STOP == 2) { dbg_probe(p, 2); return; }
    if constexpr (DBG_STOP == 20) { dbg_probe_qkv(p, 0); GRID_SYNC(4); dbg_probe_qkv(p, 1); return; }
    PH(5) { KP_OPAQUE(p); attn_phase(p, shm); }
    TSTAMP(13);
    PH(6) { KP_OPAQUE(p); fft_stage2(p, shm); }
    GRID_SYNC(4); TSTAMP(4);
    if constexpr (DBG_STOP == 3) { dbg_probe(p, 3); return; }
    PH(7) {
        KP_OPAQUE(p); unsigned char* ws = p->ws;
        pg8::Gemm g{(const bf16_t*)(ws + W_AF), (const bf16_t*)(ws + W_BTOUT), MT, 1024, 1024}; pg8::StaticOrder S; S.init(MT, 1024, G, b);
        EpiSS E{(bf16_t*)(ws + W_MIX), (float*)(ws + W_SS2)}; pg8::gemm_phase<EpiSS, pg8::StaticOrder, GEMM_ALIGN, GEMM_SP2>(lds, g, S, E);
    }
    GRID_SYNC(5); TSTAMP(5);
    if constexpr (DBG_STOP == 4) { dbg_probe(p, 4); return; }
    const bool p5split = (G == 256);
    PH(8) { KP_OPAQUE(p); if (p5split) phase5(p, 0, NPR + 8192, 0, G); else phase5(p, 0, MT, 0, G); }
    GRID_SYNC(6); TSTAMP(6);
    if constexpr (DBG_STOP == 5) { dbg_probe(p, 5); return; }
#pragma unroll 1
    for (int h = 0; h < 2; ++h) { const int hb = h * NPR;
        PH(9) { KP_OPAQUE(p); unsigned char* ws = p->ws; unsigned char* od = (unsigned char*)p->out; const bf16_t* XB1h = (const bf16_t*)(ws + W_XB) + (size_t)hb * DM;
          pg8::Gemm g{XB1h, (const bf16_t*)(ws + W_BTG), NPR, 2 * DFF, 1024}; pg8::OverlapOrder S; S.init2(h ? 4096 : 8192, h ? 4 : 2, 2 * DFF, G, b);
          EpiGU E{(const float*)(ws + W_R2), p->in[14], p->in[15], h ? (bf16_t*)(od + O_ACT1) : (bf16_t*)(ws + W_ACT), (PG8_LAS unsigned*)(lds + LDS_X), hb, h ? 4096 : 8192, S.nT};
          pg8::gemm_phase<EpiGU, pg8::OverlapOrder, GEMM_ALIGN, GEMM_SP2>(lds, g, S, E); }
        PH(8) { if (h == 0 && p5split) { KP_OPAQUE(p); phase5(p, NPR + 8192, MT, 172, 84); } }
        GRID_SYNC(7 + 2 * h); TSTAMP(7 + 2 * h);
        PH(11) { KP_OPAQUE(p); unsigned char* ws = p->ws; unsigned char* od = (unsigned char*)p->out;
          pg8::Gemm g{h ? (const bf16_t*)(od + O_ACT1) : (const bf16_t*)(ws + W_ACT), (const bf16_t*)(ws + W_BTD), NPR, 1024, DFF}; pg8::StaticOrder S; S.init(NPR, 1024, G, b);
          EpiSS E{(bf16_t*)(ws + W_MIX) + (size_t)hb * DM, (float*)(ws + W_SS3) + (size_t)hb * 16};     pg8::gemm_phase<EpiSS, pg8::StaticOrder, GEMM_ALIGN, GEMM_SP2>(lds, g, S, E); }
        if (h == 1) { GRID_SYNC(11); TSTAMP(11); }
    }
    if constexpr (DBG_STOP == 8) { dbg_probe(p, 8); return; }
    PH(12) { KP_OPAQUE(p); phase9(p); }
}

extern "C" void kernel_launch(void* const* d_in, const int* in_sizes, int n_in, void* d_out, int out_size, void* d_ws, size_t ws_size, hipStream_t stream) {
    static int grid_blocks = 0;
    if (grid_blocks == 0) {
        if (n_in != 18 || in_sizes[0] != NPR * DM || in_sizes[1] != NPR * DM || out_size != MT * DM || ws_size < W_END) {
            fprintf(stderr, "kernel_launch: unexpected shapes / workspace (n_in %d, ws %zu, need %zu); nothing launched\n", n_in, ws_size, (size_t)W_END); grid_blocks = -1; return; }
        int dev = 0, cus = 0, per_cu = 0;
        (void)hipGetDevice(&dev); (void)hipDeviceGetAttribute(&cus, hipDeviceAttributeMultiprocessorCount, dev);
        if (hipFuncSetAttribute((const void*)mega_fwd, hipFuncAttributeMaxDynamicSharedMemorySize, LDS_BYTES) != hipSuccess) { fprintf(stderr, "kernel_launch: hipFuncSetAttribute failed\n"); grid_blocks = -1; return; }
        if (hipOccupancyMaxActiveBlocksPerMultiprocessor(&per_cu, (const void*)mega_fwd, 512, LDS_BYTES) != hipSuccess || per_cu < 1) { fprintf(stderr, "kernel_launch: occupancy query failed (%d)\n", per_cu); grid_blocks = -1; return; }
        grid_blocks = cus * per_cu; if (grid_blocks > 256) grid_blocks = 256;
    }
    if (grid_blocks < 0) return;
    Params p{};
    for (int i = 0; i < 18; ++i) p.in[i] = (const float*)d_in[i];
    p.out = (float*)d_out; p.ws = (unsigned char*)d_ws;
    if (hipMemsetAsync((char*)d_ws + W_BAR, 0, XCD_BAR_WORDS * 4, stream) != hipSuccess) { fprintf(stderr, "kernel_launch: memset failed\n"); return; }
    void* args[] = {&p};
    hipError_t e = hipLaunchCooperativeKernel((const void*)mega_fwd, dim3(grid_blocks), dim3(512), args, LDS_BYTES, stream);
    if (e != hipSuccess) fprintf(stderr, "kernel_launch: cooperative launch failed: %s (grid %d)\n", hipGetErrorString(e), grid_blocks);
}
```
